# Optimizing an MI355X kernel written in HIP

```python
import math
import jax, jax.numpy as jnp
from jax import lax
import numpy as np

D_MODEL = 1024
BATCH = 4
SEQ = 8192
DEPTH = 1

S5_WIDTH = D_MODEL // 2
S5_GROUP = 16
S5_GROUPS = S5_WIDTH // S5_GROUP
S5_STATE = 64
DT_MIN = 1e-3
DT_MAX = 1e-1
RET_HEADS = 4
RET_DK = D_MODEL // 8
RET_DV = 2 * RET_DK
RET_QK_WIDTH = RET_HEADS * RET_DK
RET_V_WIDTH = RET_HEADS * RET_DV
RET_CHUNK = 128
ROPE_BASE = 10000.0
N_EXPERTS = 32
TOP_K = 4
D_FF = D_MODEL
SWIGLU_ALPHA = 1.702
SWIGLU_LIMIT = 7.0
MOE_BLOCK = 128
NORM_EPS = 1e-5
IN_WIDTH = S5_WIDTH + 2 * RET_QK_WIDTH + 2 * RET_V_WIDTH + 2 * D_MODEL
SPLIT_POINTS = (
    S5_WIDTH,
    S5_WIDTH + RET_QK_WIDTH,
    S5_WIDTH + 2 * RET_QK_WIDTH,
    S5_WIDTH + 2 * RET_QK_WIDTH + RET_V_WIDTH,
    S5_WIDTH + 2 * RET_QK_WIDTH + 2 * RET_V_WIDTH,
    S5_WIDTH + 2 * RET_QK_WIDTH + 2 * RET_V_WIDTH + D_MODEL,
)

kernel_name = "hybrid_s5_retention_gated_moe"

F32 = jnp.float32


def rms_norm(x, g):
    xf = x.astype(F32)
    y = xf * lax.rsqrt(jnp.mean(xf * xf, axis=-1, keepdims=True) + NORM_EPS)
    return (y * g.astype(F32)).astype(x.dtype)


def s5_mixer(u, lam_re, lam_im, log_dt, b_re, b_im, c_re, c_im, d_skip, w_glu, b_glu):
    bsz, seqlen, _ = u.shape
    dt = jnp.exp(log_dt.astype(F32))[:, None]
    lr, li = lam_re.astype(F32), lam_im.astype(F32)
    mag = jnp.exp(lr * dt)
    abar_re, abar_im = mag * jnp.cos(li * dt), mag * jnp.sin(li * dt)
    nr, ni = abar_re - 1.0, abar_im
    den = lr * lr + li * li
    f_re = (nr * lr + ni * li) / den
    f_im = (ni * lr - nr * li) / den
    ug = jnp.swapaxes(u, 0, 1).reshape(seqlen, bsz, S5_GROUPS, S5_GROUP).astype(F32)
    bu_re = jnp.einsum('lbgc,gnc->lbgn', ug, b_re.astype(F32))
    bu_im = jnp.einsum('lbgc,gnc->lbgn', ug, b_im.astype(F32))
    x_re = f_re * bu_re - f_im * bu_im
    x_im = f_re * bu_im + f_im * bu_re
    a_re = jnp.broadcast_to(abar_re[None, None], (seqlen, 1, S5_GROUPS, S5_STATE))
    a_im = jnp.broadcast_to(abar_im[None, None], (seqlen, 1, S5_GROUPS, S5_STATE))

    def combine(e1, e2):
        a1r, a1i, b1r, b1i = e1
        a2r, a2i, b2r, b2i = e2
        return (a2r * a1r - a2i * a1i,
                a2r * a1i + a2i * a1r,
                a2r * b1r - a2i * b1i + b2r,
                a2r * b1i + a2i * b1r + b2i)

    _, _, s_re, s_im = lax.associative_scan(combine, (a_re, a_im, x_re, x_im), axis=0)
    y = (jnp.einsum('lbgn,gcn->lbgc', s_re, c_re.astype(F32))
         - jnp.einsum('lbgn,gcn->lbgc', s_im, c_im.astype(F32)))
    y = jnp.swapaxes(y.reshape(seqlen, bsz, S5_WIDTH), 0, 1).astype(u.dtype) + d_skip * u
    z = jax.nn.gelu(y)
    return z * jax.nn.sigmoid(z @ w_glu + b_glu)


def rotary(x, positions):
    half = x.shape[-1] // 2
    inv_freq = ROPE_BASE ** (-jnp.arange(half, dtype=F32) / half)
    ang = positions.astype(F32)[..., None, None] * inv_freq
    cos, sin = jnp.cos(ang), jnp.sin(ang)
    x1, x2 = x[..., :half].astype(F32), x[..., half:].astype(F32)
    return jnp.concatenate([x1 * cos - x2 * sin, x2 * cos + x1 * sin], axis=-1).astype(x.dtype)


def retention(q, k, v):
    bsz, seqlen = q.shape[:2]
    n_chunks = seqlen // RET_CHUNK
    dt = q.dtype
    log_g = jnp.log1p(-(2.0 ** (-5.0 - jnp.arange(RET_HEADS, dtype=F32))))
    pos = jnp.arange(RET_CHUNK, dtype=F32)
    rel = pos[:, None] - pos[None, :]
    intra = jnp.where(rel >= 0, jnp.exp(log_g[:, None, None] * jnp.maximum(rel, 0.0)), 0.0).astype(dt)
    q_decay = jnp.exp(log_g[:, None] * (pos + 1.0)).astype(dt)
    k_decay = jnp.exp(log_g[:, None] * (RET_CHUNK - 1.0 - pos)).astype(dt)
    chunk_decay = jnp.exp(log_g * RET_CHUNK).astype(dt)

    def to_chunks(t):
        return t.reshape(bsz, n_chunks, RET_CHUNK, RET_HEADS, t.shape[-1]).transpose(1, 0, 3, 2, 4)

    def step(state, chunk):
        qc, kc, vc = chunk
        scores = jnp.einsum('bhid,bhjd->bhij', qc, kc) * intra
        inner = jnp.einsum('bhij,bhjv->bhiv', scores, vc)
        cross = jnp.einsum('bhid,bhdv->bhiv', qc * q_decay[:, :, None], state)
        state = chunk_decay[:, None, None] * state + jnp.einsum('bhjd,bhjv->bhdv', kc * k_decay[:, :, None], vc)
        return state, inner + cross

    state0 = jnp.zeros((bsz, RET_HEADS, RET_DK, RET_DV), dt)
    _, out = lax.scan(step, state0, (to_chunks(q), to_chunks(k), to_chunks(v)))
    return out.transpose(1, 0, 3, 2, 4).reshape(bsz, seqlen, RET_HEADS, RET_DV)


def head_group_norm(y, g):
    yf = y.astype(F32)
    mu = jnp.mean(yf, axis=-1, keepdims=True)
    var = jnp.mean(jnp.square(yf - mu), axis=-1, keepdims=True)
    yn = (yf - mu) * lax.rsqrt(var + NORM_EPS)
    yn = yn.reshape(y.shape[0], y.shape[1], RET_V_WIDTH) * g.astype(F32)
    return yn.astype(y.dtype)


def clamped_swiglu(gu):
    x_glu = jnp.minimum(gu[..., ::2], SWIGLU_LIMIT)
    x_lin = jnp.clip(gu[..., 1::2], -SWIGLU_LIMIT, SWIGLU_LIMIT)
    return x_glu * jax.nn.sigmoid(SWIGLU_ALPHA * x_glu) * (x_lin + 1.0)


def moe_ffn(h, router_w, router_b, w1, b1, w2, b2):
    bsz, seqlen, d = h.shape
    n_tok = bsz * seqlen
    ht = h.reshape(n_tok, d)
    logits = ht.astype(F32) @ router_w.astype(F32) + router_b.astype(F32)
    top_vals, top_idx = lax.top_k(logits, TOP_K)
    gates = jax.nn.softmax(top_vals, axis=-1)
    n_assign = n_tok * TOP_K
    flat_e = top_idx.reshape(n_assign)
    flat_tok = jnp.arange(n_assign, dtype=jnp.int32) // TOP_K
    order = jnp.argsort(flat_e)
    e_sorted = flat_e[order]
    tok_sorted = flat_tok[order]
    gate_sorted = gates.reshape(n_assign)[order]
    counts = jnp.bincount(flat_e, length=N_EXPERTS)
    padded = (counts + MOE_BLOCK - 1) // MOE_BLOCK * MOE_BLOCK
    start = jnp.cumsum(counts) - counts
    pend = jnp.cumsum(padded)
    pstart = pend - padded
    dest = pstart[e_sorted] + jnp.arange(n_assign, dtype=jnp.int32) - start[e_sorted]
    n_blocks = (n_assign + MOE_BLOCK - 1) // MOE_BLOCK + N_EXPERTS
    n_rows = n_blocks * MOE_BLOCK
    x_rows = jnp.zeros((n_rows, d), h.dtype).at[dest].set(ht[tok_sorted])
    block_start = jnp.arange(n_blocks, dtype=pend.dtype) * MOE_BLOCK
    block_expert = jnp.minimum(jnp.searchsorted(pend, block_start, side='right'), N_EXPERTS - 1)

    def expert_block(args):
        xb, e = args
        gu = xb @ w1[e] + b1[e]
        return clamped_swiglu(gu) @ w2[e] + b2[e]

    y_rows = lax.map(expert_block, (x_rows.reshape(n_blocks, MOE_BLOCK, d), block_expert))
    y_rows = y_rows.reshape(n_rows, d)
    y = jax.ops.segment_sum(y_rows[dest] * gate_sorted[:, None].astype(h.dtype), tok_sorted,
                            num_segments=n_tok)
    return y.reshape(bsz, seqlen, d)


def setup_inputs(seed: int = 0) -> dict:
    key = jax.random.key(seed)
    ks = jax.random.split(key, 24)
    L = DEPTH
    G, N, W = S5_GROUPS, S5_STATE, S5_WIDTH

    def nrm(k, shape, scale):
        return jax.random.normal(k, shape, F32) * scale

    x = nrm(ks[0], (BATCH, SEQ, D_MODEL), 1.0)
    positions = jnp.broadcast_to(jnp.arange(SEQ, dtype=jnp.int32)[None, :], (BATCH, SEQ))
    norm_mix_g = 1.0 + nrm(ks[1], (L, D_MODEL), 0.02)
    w_in = nrm(ks[2], (L, D_MODEL, IN_WIDTH), D_MODEL ** -0.5)
    s5_lambda_re = -0.5 + nrm(ks[3], (L, G, N), 0.01)
    s5_lambda_im = math.pi * jnp.arange(N, dtype=F32) + nrm(ks[4], (L, G, N), 0.01)
    s5_log_dt = jax.random.uniform(ks[5], (L, G), F32, math.log(DT_MIN), math.log(DT_MAX))
    s5_b_re = nrm(ks[6], (L, G, N, S5_GROUP), (2 * S5_GROUP) ** -0.5)
    s5_b_im = nrm(ks[7], (L, G, N, S5_GROUP), (2 * S5_GROUP) ** -0.5)
    s5_c_re = nrm(ks[8], (L, G, S5_GROUP, N), (2 * N) ** -0.5)
    s5_c_im = nrm(ks[9], (L, G, S5_GROUP, N), (2 * N) ** -0.5)
    s5_d = nrm(ks[10], (L, W), 1.0)
    s5_w_glu = nrm(ks[11], (L, W, W), W ** -0.5)
    s5_b_glu = nrm(ks[12], (L, W), 0.01)
    ret_gn_g = 1.0 + nrm(ks[13], (L, RET_V_WIDTH), 0.02)
    w_branch_s5 = nrm(ks[14], (L, W, D_MODEL), W ** -0.5)
    w_branch_ret = nrm(ks[15], (L, RET_V_WIDTH, D_MODEL), RET_V_WIDTH ** -0.5)
    w_out = nrm(ks[16], (L, D_MODEL, D_MODEL), D_MODEL ** -0.5)
    norm_ffn_g = 1.0 + nrm(ks[17], (L, D_MODEL), 0.02)
    router_w = nrm(ks[18], (L, D_MODEL, N_EXPERTS), D_MODEL ** -0.5)
    router_b = nrm(ks[19], (L, N_EXPERTS), 0.01)
    expert_w1 = nrm(ks[20], (L, N_EXPERTS, D_MODEL, 2 * D_FF), D_MODEL ** -0.5)
    expert_b1 = nrm(ks[21], (L, N_EXPERTS, 2 * D_FF), 0.01)
    expert_w2 = nrm(ks[22], (L, N_EXPERTS, D_FF, D_MODEL), D_FF ** -0.5)
    k23a, k23b = jax.random.split(ks[23])
    expert_b2 = nrm(k23a, (L, N_EXPERTS, D_MODEL), 0.01)
    norm_final_g = 1.0 + nrm(k23b, (D_MODEL,), 0.02)
    return {"x": x, "positions": positions, "norm_mix_g": norm_mix_g, "w_in": w_in,
            "s5_lambda_re": s5_lambda_re, "s5_lambda_im": s5_lambda_im, "s5_log_dt": s5_log_dt,
            "s5_b_re": s5_b_re, "s5_b_im": s5_b_im, "s5_c_re": s5_c_re, "s5_c_im": s5_c_im,
            "s5_d": s5_d, "s5_w_glu": s5_w_glu, "s5_b_glu": s5_b_glu, "ret_gn_g": ret_gn_g,
            "w_branch_s5": w_branch_s5, "w_branch_ret": w_branch_ret, "w_out": w_out,
            "norm_ffn_g": norm_ffn_g, "router_w": router_w, "router_b": router_b,
            "expert_w1": expert_w1, "expert_b1": expert_b1, "expert_w2": expert_w2,
            "expert_b2": expert_b2, "norm_final_g": norm_final_g}


def reference(x, positions, norm_mix_g, w_in, s5_lambda_re, s5_lambda_im, s5_log_dt,
              s5_b_re, s5_b_im, s5_c_re, s5_c_im, s5_d, s5_w_glu, s5_b_glu, ret_gn_g,
              w_branch_s5, w_branch_ret, w_out, norm_ffn_g, router_w, router_b,
              expert_w1, expert_b1, expert_w2, expert_b2, norm_final_g):
    bsz, seqlen, _ = x.shape
    for layer in range(DEPTH):
        h = rms_norm(x, norm_mix_g[layer])
        proj = h @ w_in[layer]
        u_s5, q, k, v, g_ret, gate_a, gate_b = jnp.split(proj, SPLIT_POINTS, axis=-1)
        y_s5 = s5_mixer(u_s5, s5_lambda_re[layer], s5_lambda_im[layer], s5_log_dt[layer],
                        s5_b_re[layer], s5_b_im[layer], s5_c_re[layer], s5_c_im[layer],
                        s5_d[layer], s5_w_glu[layer], s5_b_glu[layer])
        y_a = y_s5 @ w_branch_s5[layer]
        q = rotary(q.reshape(bsz, seqlen, RET_HEADS, RET_DK), positions)
        k = rotary(k.reshape(bsz, seqlen, RET_HEADS, RET_DK), positions) * (RET_DK ** -0.5)
        v = v.reshape(bsz, seqlen, RET_HEADS, RET_DV)
        ret = head_group_norm(retention(q, k, v), ret_gn_g[layer])
        y_b = (jax.nn.silu(g_ret) * ret) @ w_branch_ret[layer]
        merged = jax.nn.sigmoid(gate_a) * y_a + jax.nn.sigmoid(gate_b) * y_b
        x = x + merged @ w_out[layer]
        h2 = rms_norm(x, norm_ffn_g[layer])
        x = x + moe_ffn(h2, router_w[layer], router_b[layer], expert_w1[layer],
                        expert_b1[layer], expert_w2[layer], expert_b2[layer])
    return rms_norm(x, norm_final_g)
```

```cpp
#include <hip/hip_runtime.h>
#include <cstdio>
#include <cstdint>

#define LAS __attribute__((address_space(3)))
#define GAS __attribute__((address_space(1)))
typedef unsigned short bf16_t;
typedef short bf16x8 __attribute__((ext_vector_type(8)));
typedef float f32x4 __attribute__((ext_vector_type(4)));
typedef float f32x2 __attribute__((ext_vector_type(2)));
typedef unsigned u32x4 __attribute__((ext_vector_type(4)));
typedef unsigned u32x2 __attribute__((ext_vector_type(2)));
typedef int i32x4 __attribute__((ext_vector_type(4)));
typedef int i32x8 __attribute__((ext_vector_type(8)));

#ifndef MK_N_LAUNCHES
#define MK_N_LAUNCHES 1
#endif

constexpr int NB = 4, SEQ = 8192, T = NB * SEQ, DM = 1024, INW = 5632;
constexpr int S5W = 512, S5G = 32, S5N = 64, S5Q = 32, S5NCH = SEQ / S5Q, S5ROWS = NB * S5NCH, S5K = 640;
constexpr int RH = 4, RDK = 128, RDV = 256, RC = 128, RNC = SEQ / RC;
constexpr int NE = 32, DFF = 1024, MAXTILES = 544, MAXROWS = MAXTILES * 256;
constexpr float NORM_EPS = 1e-5f;

__device__ __forceinline__ unsigned pkbf(float lo, float hi) { typedef __bf16 bf2 __attribute__((ext_vector_type(2))); f32x2 v = {lo, hi}; bf2 b = __builtin_convertvector(v, bf2); return __builtin_bit_cast(unsigned, b); }
__device__ __forceinline__ unsigned pkfp8x4(float a, float b, float c, float d) { int p = 0; p = __builtin_amdgcn_cvt_pk_fp8_f32(a, b, p, false); p = __builtin_amdgcn_cvt_pk_fp8_f32(c, d, p, true); return (unsigned)p; }
__device__ __forceinline__ float bflo(unsigned u) { return __uint_as_float(u << 16); }
__device__ __forceinline__ float bfhi(unsigned u) { return __uint_as_float(u & 0xffff0000u); }
__device__ __forceinline__ float fsigmoid(float x) { return __builtin_amdgcn_rcpf(1.0f + __builtin_amdgcn_exp2f(-1.4426950408889634f * x)); }
typedef float f32x2 __attribute__((ext_vector_type(2)));
__device__ __forceinline__ f32x2 fsigmoid2(f32x2 x) { const f32x2 t = x * -1.4426950408889634f; const f32x2 d = f32x2{__builtin_amdgcn_exp2f(t.x), __builtin_amdgcn_exp2f(t.y)} + 1.0f; return f32x2{__builtin_amdgcn_rcpf(d.x), __builtin_amdgcn_rcpf(d.y)}; }
__device__ __forceinline__ float wave_sum(float v) {
#pragma unroll
    for (int o = 1; o < 64; o <<= 1) v += __shfl_xor(v, o);
    return v;
}
#define LDS_WAIT() asm volatile("s_waitcnt lgkmcnt(0)" ::: "memory")
#define VM_WAIT() asm volatile("s_waitcnt vmcnt(0)" ::: "memory")
#define LDS_BARRIER() do { asm volatile("s_waitcnt lgkmcnt(0)" ::: "memory"); __builtin_amdgcn_s_barrier(); asm volatile("" ::: "memory"); } while (0)

namespace pg8 {
constexpr int BM = 256, BK = 64, HALF = 128, HTB = HALF * BK * 2, STAGE_BYTES = 8 * HTB, NXCD = 8, WGM = 8;
constexpr int TOKBUF_OFF = 131072 + 13312;
constexpr int ROWBUF_OFF = 131072 + 1024;
__host__ __device__ __forceinline__ int lds_byte(int r, int c) { const int st = (r >> 4) * 2 + (c >> 5), rr = r & 15, cc = c & 31, ob = rr * 64 + cc * 2; return st * 1024 + (ob ^ (((ob >> 9) & 1) << 5)); }
__host__ __device__ __forceinline__ void stage_rc(int b, int& R, int& C) { const int st = b / 1024, sb = b % 1024, swz = sb ^ (((sb >> 9) & 1) << 5); R = (st >> 1) * 16 + swz / 64; C = (st & 1) * 32 + (swz % 64) / 2; }
__host__ __device__ __forceinline__ int perm32(int rho) { const int n = rho >> 4, i = rho & 15; return 8 * (i >> 2) + 4 * n + (i & 3); }

struct Unit { int pm, pn, arow, brow, aux, slot, seg; };
struct Gemm { const void* A; const void* Bt; int lda, ldb, K; const void* A2 = nullptr; int lda2 = 0, K2 = 0; };

struct StaticOrder {
    static constexpr bool GATHER = false, ROWINFO = false, CHAIN = false;
    int nM, nN, nwg, G, c;
    __device__ void init(int nM_, int nN_, int G_, int c_) { nM = nM_; nN = nN_; nwg = nM * nN; G = G_; c = c_; }
    __device__ __forceinline__ bool tile(int i, int& pm, int& pn) const {
        const long L = (long)i * G + c; if (L >= nwg) return false;
        int wgid = (int)L; { const int q = nwg / NXCD, r = nwg % NXCD, xcd = wgid % NXCD, off = wgid / NXCD; wgid = (xcd < r ? xcd * (q + 1) : r * (q + 1) + (xcd - r) * q) + off; }
        const int nig = WGM * nN, gid = wgid / nig, fm = gid * WGM, gsz = (nM - fm) < WGM ? (nM - fm) : WGM;
        pm = fm + ((wgid % nig) % gsz); pn = (wgid % nig) / gsz; return true;
    }
    __device__ __forceinline__ bool next(int i, Unit& u) const { if (!tile(i, u.pm, u.pn)) return false; u.arow = u.pm * BM; u.brow = u.pn * BM; u.aux = 0; return true; }
};
struct GroupOrder {
    static constexpr bool GATHER = false, ROWINFO = false, CHAIN = false;
    int nMg, nNg, per, nwg, G, c, arows, brows;
    __device__ void init(int ng, int nMg_, int nNg_, int arows_, int brows_, int G_, int c_) { nMg = nMg_; nNg = nNg_; per = nMg * nNg; nwg = ng * per; G = G_; c = c_; arows = arows_; brows = brows_; }
    __device__ __forceinline__ bool next(int i, Unit& u) const {
        const long L = (long)i * G + c; if (L >= nwg) return false;
        const int g = (int)L / per, r = (int)L % per; u.pm = r % nMg; u.pn = r / nMg; u.arow = g * arows + u.pm * BM; u.brow = g * brows + u.pn * BM; u.aux = g; return true;
    }
};
struct ChainOrder {
    static constexpr bool GATHER = false, ROWINFO = false, CHAIN = true;
    StaticOrder so;
    __device__ __forceinline__ bool next(int i, Unit& u) const { if (!so.tile(i >> 1, u.pm, u.pn)) return false; u.arow = u.pm * BM; u.brow = u.pn * BM; u.aux = 0; u.seg = i & 1; return true; }
};
template <bool GATHER_> struct ExpertOrder {
    static constexpr bool GATHER = GATHER_, ROWINFO = false, CHAIN = false;
    const float* egate; int amask = -1;
    StaticOrder so; const LAS unsigned char* tile_e; int nfull; const LAS int* pst; const LAS int* cl; const int* etok;
    __device__ __forceinline__ bool next(int i, Unit& u) const {
        if (!so.tile(i, u.pm, u.pn)) return false;
        const int e = (int)tile_e[u.pm]; u.arow = GATHER_ ? 0 : (u.pm * BM) & amask; u.brow = e * nfull + u.pn * BM; u.aux = e; return true;
    }
    __device__ __forceinline__ const int* tok_src(const Unit& u, int rho) const { const int e = u.aux, i = u.pm * BM + rho - pst[e]; return etok + (size_t)e * 32768 + (i < cl[e] ? i : 0); }
    __device__ __forceinline__ const float* gate_src(const Unit& u, int rho) const { const int e = u.aux, i = u.pm * BM + rho - pst[e]; return egate + (size_t)e * 32768 + (i < cl[e] ? i : 0); }
};

template <class Epi, class Sched, bool ALIGN_EPI>
__device__ __forceinline__ void gemm_phase(LAS unsigned char* lds, const Gemm g, const Sched& S, const Epi& E) {
    int tid_ = threadIdx.x; asm volatile("" : "+v"(tid_));
    const int tid = tid_, wid = __builtin_amdgcn_readfirstlane(tid >> 6), lane = tid & 63, wr = wid >> 2, wc = wid & 3, fr = lane & 15, fq = lane >> 4;
    const int nt0 = g.K / (BK * 2);
    unsigned voffA[2], voffB[2]; int stR[2], stC[2];
#pragma unroll
    for (int i = 0; i < 2; ++i) { int R, C; stage_rc(tid * 16 + i * 8192, R, C); const int Rb = Epi::PERM ? ((R & ~31) + perm32(R & 31)) : R; stR[i] = R; stC[i] = C;
        voffA[i] = (unsigned)(R * g.lda + C * 2); voffB[i] = (unsigned)(Rb * g.ldb + C * 2); }
    unsigned gv[2][2];
#pragma unroll
    for (int h = 0; h < 2; ++h)
#pragma unroll
        for (int i = 0; i < 2; ++i) gv[h][i] = voffA[i] + (unsigned)(h * HALF * g.lda);
    LAS int* tokbuf = (LAS int*)(lds + TOKBUF_OFF);
    const size_t kstep = (size_t)(BK * 2);
    const size_t hstepB = (size_t)HALF * g.ldb;
    const unsigned ldsw = (unsigned)wid * 1024u;
    const unsigned ldsbase = (unsigned)(size_t)lds + ldsw;
    const int aoff = lds_byte(wr * 64 + fr, fq * 8), boff = lds_byte(wc * 32 + fr, fq * 8);
#define PG8_SA(b, h) (((b) * 2 + (h)) * HTB)
#define PG8_SB(b, h) ((4 + (b) * 2 + (h)) * HTB)
#define PG8_STAGE(bufoff, gbase, voff) do { _Pragma("unroll") for (int _i = 0; _i < 2; ++_i) \
        asm volatile("s_mov_b32 m0, %2\n\ts_nop 0\n\tglobal_load_lds_dwordx4 %0, %1" :: "v"((voff)[_i]), "s"((const char*)(gbase)), "s"(ldsbase + (unsigned)((bufoff) + _i * 8192)) : "memory", "m0"); } while (0)
#define PG8_STAGE_A(bufoff, kptr, h) PG8_STAGE(bufoff, kptr, gv[h])
#define PG8_LD8(p) __builtin_shufflevector(*(const LAS i32x4*)(p), *(const LAS i32x4*)((p) + 1024), 0, 1, 2, 3, 4, 5, 6, 7)
#define PG8_LDA(dst, b, h) do { _Pragma("unroll") for (int m = 0; m < 4; ++m) dst[m] = PG8_LD8(lds + PG8_SA(b, h) + aoff + m * 2048); } while (0)
#define PG8_LDB(dst, b, h) do { _Pragma("unroll") for (int n = 0; n < 2; ++n) dst[n] = PG8_LD8(lds + PG8_SB(b, h) + boff + n * 2048); } while (0)
#define PG8_HALF(x, k) __builtin_bit_cast(bf16x8, __builtin_shufflevector(x, x, 4 * (k), 4 * (k) + 1, 4 * (k) + 2, 4 * (k) + 3))
#define PG8_MMA(ai, bj, At, Bt) do { __builtin_amdgcn_s_setprio(1); _Pragma("unroll") for (int m = 0; m < 4; ++m) _Pragma("unroll") for (int n = 0; n < 2; ++n) { \
        if constexpr (Epi::FP8) {   \
            acc[ai][bj][m][n] = __builtin_amdgcn_mfma_scale_f32_16x16x128_f8f6f4(Bt[n], At[m], acc[ai][bj][m][n], 0, 0, 0, 0x7a7a7a7a, 0, 0x7f7f7f7f); \
        } else { acc[ai][bj][m][n] = __builtin_amdgcn_mfma_f32_16x16x32_bf16(PG8_HALF(Bt[n], 0), PG8_HALF(At[m], 0), acc[ai][bj][m][n], 0, 0, 0); \
                 acc[ai][bj][m][n] = __builtin_amdgcn_mfma_f32_16x16x32_bf16(PG8_HALF(Bt[n], 1), PG8_HALF(At[m], 1), acc[ai][bj][m][n], 0, 0, 0); } } \
        __builtin_amdgcn_s_setprio(0); } while (0)
#define PG8_WAIT_V(n) asm volatile("s_waitcnt vmcnt(" #n ")" ::: "memory")
#define PG8_WAIT_L(n) asm volatile("s_waitcnt lgkmcnt(" #n ")" ::: "memory")
#define PG8_BAR __builtin_amdgcn_s_barrier()
#define PG8_SCHED __builtin_amdgcn_sched_barrier(0)
    Unit cur, nxt; int ui = 0;
    if (!S.next(0, cur)) return;
    typename Epi::Pre pre = E.prefetch(cur, wr, wc, fr, fq);
    f32x4 acc[2][2][4][2];
#pragma unroll
    for (int a = 0; a < 2; ++a)
#pragma unroll
        for (int b = 0; b < 2; ++b)
#pragma unroll
            for (int m = 0; m < 4; ++m)
#pragma unroll
                for (int n = 0; n < 2; ++n) { typedef unsigned long long u64x2 __attribute__((ext_vector_type(2))); u64x2 z;
                    asm volatile("v_mov_b64 %0, 0" : "=v"(z.x)); asm volatile("v_mov_b64 %0, 0" : "=v"(z.y)); acc[a][b][m][n] = __builtin_bit_cast(f32x4, z); }
    i32x8 At[4], B0[2], B1[2];
    const char* cA = (const char*)g.A + (size_t)cur.arow * g.lda; const char* cB = (const char*)g.Bt + (size_t)cur.brow * g.ldb;
    if constexpr (Sched::GATHER) {
#pragma unroll
        for (int h = 0; h < 2; ++h)
#pragma unroll
            for (int i = 0; i < 2; ++i) { const int tokk = *S.tok_src(cur, HALF * h + stR[i]); gv[h][i] = (unsigned)(tokk >> 2) * (unsigned)g.lda + (unsigned)stC[i] * 2u; }
    }
    if constexpr (Sched::ROWINFO) {
        LAS int* rb = (LAS int*)(lds + ROWBUF_OFF); if (tid < 256) rb[tid] = *S.tok_src(cur, tid); else rb[tid] = __float_as_int(*S.gate_src(cur, tid - 256));
    }
    PG8_STAGE(PG8_SB(0, 0), cB, voffB); PG8_STAGE(PG8_SB(0, 1), cB + hstepB, voffB); PG8_STAGE_A(PG8_SA(0, 0), cA, 0); PG8_STAGE_A(PG8_SA(0, 1), cA, 1);
    if (wr == 1) PG8_BAR;
    PG8_WAIT_V(2); PG8_BAR;
    PG8_STAGE(PG8_SB(1, 0), cB + kstep, voffB); PG8_STAGE_A(PG8_SA(1, 0), cA + kstep, 0); PG8_STAGE(PG8_SB(1, 1), cB + hstepB + kstep, voffB);
    PG8_WAIT_V(6); PG8_BAR;
    for (;;) {
        const bool has_next = S.next(ui + 1, nxt);
        const char* nA = has_next ? (const char*)g.A + (size_t)nxt.arow * g.lda : cA; const char* nB = has_next ? (const char*)g.Bt + (size_t)nxt.brow * g.ldb : cB;
        int nt = nt0;
        if constexpr (Sched::CHAIN) { if (has_next && nxt.seg) { nA = (const char*)g.A2 + (size_t)nxt.arow * g.lda2; nB += g.K; } if (cur.seg) nt = g.K2 / (BK * 2); }
        if constexpr (Sched::GATHER) {
            if (has_next && wid < 4) __builtin_amdgcn_global_load_lds((const unsigned*)S.tok_src(nxt, 64 * wid + lane), (LAS unsigned*)(tokbuf + ((ui + 1) & 1) * 256 + 64 * wid), 4, 0, 0);
        }
        if constexpr (Sched::ROWINFO) {
            if (has_next) { LAS unsigned* dst = (LAS unsigned*)(lds + ROWBUF_OFF) + ((ui + 1) % 3) * 512 + 64 * wid;
                const unsigned* src = wid < 4 ? (const unsigned*)S.tok_src(nxt, 64 * wid + lane) : (const unsigned*)S.gate_src(nxt, 64 * (wid - 4) + lane);
                __builtin_amdgcn_global_load_lds(src, dst, 4, 0, 0); }
        }
#pragma nounroll
        for (int t = 0; t < nt; t += 2) {
            const bool last = (t == nt - 2);
            const char* a1 = cA + (size_t)(t + 1) * kstep;
            const char* a2 = last ? nA : cA + (size_t)(t + 2) * kstep; const char* b2 = last ? nB : cB + (size_t)(t + 2) * kstep;
            const char* a3 = a2 + kstep; const char* b3 = b2 + kstep;
            PG8_STAGE_A(PG8_SA(1, 1), a1, 1); PG8_LDB(B0, 0, 0); PG8_LDB(B1, 0, 1); PG8_SCHED; PG8_LDA(At, 0, 0);
            if constexpr (!Sched::GATHER && !Sched::CHAIN) { if (last && has_next) { asm volatile("" : "+v"(gv[0][0]), "+v"(gv[0][1]), "+v"(gv[1][0]), "+v"(gv[1][1])); } }
            if constexpr (Sched::CHAIN) {
                if (last && has_next) { const int ldn = nxt.seg ? g.lda2 : g.lda;
#pragma unroll
                    for (int h = 0; h < 2; ++h)
#pragma unroll
                        for (int i = 0; i < 2; ++i) gv[h][i] = (unsigned)((HALF * h + stR[i]) * ldn + stC[i] * 2); }
            }
            if constexpr (Sched::GATHER) {
                if (last && has_next) {
#pragma unroll
                    for (int h = 0; h < 2; ++h)
#pragma unroll
                        for (int i = 0; i < 2; ++i) { const int tokk = tokbuf[((ui + 1) & 1) * 256 + HALF * h + stR[i]]; gv[h][i] = (unsigned)(tokk >> 2) * (unsigned)g.lda + (unsigned)stC[i] * 2u; }
                }
            }
            PG8_WAIT_V(8); PG8_WAIT_L(0); PG8_BAR; PG8_MMA(0, 0, At, B0); PG8_MMA(0, 1, At, B1); PG8_BAR; PG8_SCHED;
            PG8_STAGE(PG8_SB(0, 0), b2, voffB); PG8_STAGE(PG8_SB(0, 1), b2 + hstepB, voffB); PG8_STAGE_A(PG8_SA(0, 0), a2, 0); PG8_LDA(At, 0, 1);
            PG8_WAIT_V(8); PG8_WAIT_L(0); PG8_BAR; PG8_MMA(1, 0, At, B0); PG8_MMA(1, 1, At, B1); PG8_BAR; PG8_SCHED;
            PG8_STAGE_A(PG8_SA(0, 1), a2, 1); PG8_LDB(B0, 1, 0); PG8_LDB(B1, 1, 1); PG8_SCHED; PG8_LDA(At, 1, 0);
            PG8_WAIT_V(8); PG8_WAIT_L(0); PG8_BAR; PG8_MMA(0, 0, At, B0); PG8_MMA(0, 1, At, B1); PG8_BAR; PG8_SCHED;
            PG8_STAGE(PG8_SB(1, 0), b3, voffB); PG8_STAGE(PG8_SB(1, 1), b3 + hstepB, voffB); PG8_STAGE_A(PG8_SA(1, 0), a3, 0); PG8_LDA(At, 1, 1);
            PG8_WAIT_V(8); PG8_WAIT_L(0); PG8_BAR; PG8_MMA(1, 0, At, B0); PG8_MMA(1, 1, At, B1); PG8_BAR; PG8_SCHED;
        }
        if constexpr (ALIGN_EPI) { if (wr == 0) PG8_BAR; }
        { int fr_e = fr, fq_e = fq; asm volatile("" : "+v"(fr_e), "+v"(fq_e));
          cur.slot = ui % 3; E(acc, cur, wr, wc, fr_e, fq_e, pre); }
        if (!has_next) break;
        if (!(Sched::CHAIN && cur.seg == 0)) {
#pragma unroll
        for (int a = 0; a < 2; ++a)
#pragma unroll
            for (int b = 0; b < 2; ++b)
#pragma unroll
                for (int m = 0; m < 4; ++m)
#pragma unroll
                    for (int n = 0; n < 2; ++n) { typedef unsigned long long u64x2 __attribute__((ext_vector_type(2))); u64x2 z;
                    asm volatile("v_mov_b64 %0, 0" : "=v"(z.x)); asm volatile("v_mov_b64 %0, 0" : "=v"(z.y)); acc[a][b][m][n] = __builtin_bit_cast(f32x4, z); }
        }
        cur = nxt; cA = nA; cB = nB; ++ui;
        pre = E.prefetch(cur, wr, wc, fr, fq);
        if constexpr (ALIGN_EPI) { if (wr == 1) PG8_BAR; }
    }
    PG8_WAIT_V(0);
    if constexpr (!ALIGN_EPI) { if (wr == 0) PG8_BAR; }
    PG8_BAR;
#undef PG8_SA
#undef PG8_SB
#undef PG8_STAGE
#undef PG8_STAGE_A
#undef PG8_LDA
#undef PG8_LDB
#undef PG8_MMA
#undef PG8_LD8
#undef PG8_HALF
#undef PG8_WAIT_V
#undef PG8_WAIT_L
#undef PG8_BAR
#undef PG8_SCHED
}
}
using pg8::Unit;

constexpr size_t MiB = 1u << 20;
constexpr size_t WS_CTL = 0, CTL_ZERO_BYTES = 64 * 1024;
constexpr int IN_BF_TILES = 6;
constexpr size_t WS_WIN = 2 * MiB;
constexpr size_t WS_WIN8 = 6 * MiB;
constexpr size_t WS_WGLU = 13 * MiB;
constexpr size_t WS_WCAT = 14 * MiB;
constexpr size_t WS_WOUT = 17 * MiB;
constexpr size_t WS_ROPE = 19 * MiB;
constexpr size_t WS_BTY = 35 * MiB;
constexpr size_t WS_BTV = 55 * MiB;
constexpr size_t WS_DBUF = 63 * MiB;
constexpr size_t WS_W1 = 64 * MiB;
constexpr size_t WS_W2 = 192 * MiB;
constexpr size_t WS_H = 256 * MiB;
constexpr size_t WS_Z = 256 * MiB, WS_YS5 = 288 * MiB;
constexpr size_t WS_AS5 = 320 * MiB;
constexpr size_t WS_VBUF = 360 * MiB;
constexpr size_t WS_Q = 376 * MiB, WS_K = 408 * MiB, WS_V = 440 * MiB;
constexpr size_t WS_GS = 536 * MiB, WS_SA = 600 * MiB, WS_SB = 664 * MiB;
constexpr size_t WS_KV = 728 * MiB;
constexpr size_t WS_ST = 856 * MiB;
constexpr size_t WS_RETG = 920 * MiB;
constexpr size_t WS_H8 = 984 * MiB;
constexpr size_t WS_MERGED = 440 * MiB;
constexpr size_t WS_H2 = 256 * MiB;
constexpr size_t WS_XS = 320 * MiB;
constexpr size_t WS_YK = 320 * MiB;
constexpr size_t WS_ACT = 592 * MiB;
constexpr size_t WS_ETOK = 864 * MiB, WS_INV = 872 * MiB, WS_GATE4 = 873 * MiB;
constexpr size_t WS_X1 = 728 * MiB;
constexpr size_t WS_ROWSS = 876 * MiB;
constexpr size_t WS_END = 1024 * MiB;
static_assert(WS_RETG + 64 * MiB <= WS_END && WS_ACT + (size_t)MAXROWS * 2048 <= WS_ETOK && WS_XS + (size_t)MAXROWS * 2048 <= WS_ACT, "d_ws map");
constexpr int CW_ECNT = 64;
constexpr int CW_QUEUE = 2112;
constexpr int CW_BAR = 4096;

constexpr int RING_BYTES = 131072;
constexpr int LDSCTL_OFF = RING_BYTES;
constexpr int LDS_TILEE = LDSCTL_OFF + 256;
constexpr int LDS_P8 = LDSCTL_OFF + 1024;
constexpr int LDS_PST = LDSCTL_OFF + 12288, LDS_CNT = LDSCTL_OFF + 12288 + 256;
constexpr int LDS_BYTES = 147456;

#define XB_TMO      128
#define XB_XCNT(j)  (256  + 64 * (j))
#define XB_XSUB(j)  (1280 + 64 * (j))
#define XB_XGEN(j)  (2304 + 64 * (j))
#define XB_TOP      3328
#define XB_TOPGEN   3392
#define XCD_BAR_WORDS 3456
#define XB_SPIN_CAP (1u << 18)
__device__ __forceinline__ unsigned xb_ld(unsigned* p)              { return __hip_atomic_load(p, __ATOMIC_RELAXED, __HIP_MEMORY_SCOPE_AGENT); }
__device__ __forceinline__ unsigned xb_add(unsigned* p, unsigned v) { return __hip_atomic_fetch_add(p, v, __ATOMIC_RELAXED, __HIP_MEMORY_SCOPE_AGENT); }
__device__ __forceinline__ unsigned xb_xcc_id() { return (unsigned)__builtin_amdgcn_s_getreg((3 << 11) | 20) & 0xFu; }
#define XB_SPIN(cond, bar) do { unsigned _sp = 0; while (cond) { __builtin_amdgcn_s_sleep(1); \
    if ((++_sp & 255u) == 0u) { if (xb_ld(&(bar)[XB_TMO])) break; if (_sp > XB_SPIN_CAP) { atomicAdd(&(bar)[XB_TMO], 1u); break; } } } } while (0)
struct XcdBarrier { unsigned* bar; unsigned x; volatile LAS unsigned* st; };
__device__ __forceinline__ XcdBarrier xcd_barrier_post(unsigned* bar, volatile LAS unsigned* st) {
    XcdBarrier b; b.bar = bar; b.x = xb_xcc_id(); b.st = st;
    if (threadIdx.x == 0) (void)xb_add(&bar[XB_XCNT(b.x)], 1u);
    return b;
}
__device__ __forceinline__ void xcd_barrier_complete(unsigned* bar, unsigned x, unsigned& nloc, unsigned& nx) {
    const unsigned G = gridDim.x * gridDim.y * gridDim.z;
    unsigned sum, cnt, mine, sp = 0u;
    for (;;) {
        sum = 0u; cnt = 0u; mine = 0u;
#pragma unroll
        for (unsigned j = 0; j < 16; ++j) { const unsigned c = xb_ld(&bar[XB_XCNT(j)]); sum += c; cnt += (c > 0u) ? 1u : 0u; mine = (j == x) ? c : mine; }
        if (sum == G) break;
        __builtin_amdgcn_s_sleep(1);
        if ((++sp & 255u) == 0u) { if (xb_ld(&bar[XB_TMO])) break; if (sp > XB_SPIN_CAP) { atomicAdd(&bar[XB_TMO], 1u); break; } }
    }
    nloc = mine > 0u ? mine : 1u; nx = cnt > 0u ? cnt : 1u;
}
__device__ __forceinline__ void xcd_barrier(const XcdBarrier& b) {
    asm volatile("s_waitcnt vmcnt(0)" ::: "memory");
    __syncthreads();
    if (threadIdx.x == 0) {
        unsigned* bar = b.bar;
        __builtin_amdgcn_s_waitcnt(0);
        unsigned nloc = b.st[0], nx = b.st[1];
        if (nloc == 0u) { xcd_barrier_complete(bar, b.x, nloc, nx); b.st[0] = nloc; b.st[1] = nx; }
        const unsigned old = xb_add(&bar[XB_XSUB(b.x)], 1u);
        const unsigned gen = old / nloc;
        if (old + 1u == (gen + 1u) * nloc) {
            __builtin_amdgcn_fence(__ATOMIC_RELEASE, "agent");
            asm volatile("s_waitcnt vmcnt(0)" ::: "memory");
            const unsigned og = xb_add(&bar[XB_TOP], 1u);
            const unsigned tg = og / nx;
            if (og + 1u == (tg + 1u) * nx) xb_add(&bar[XB_TOPGEN], 1u);
            else XB_SPIN(xb_ld(&bar[XB_TOPGEN]) == tg, bar);
            __builtin_amdgcn_fence(__ATOMIC_ACQUIRE, "agent");
            xb_add(&bar[XB_XGEN(b.x)], 1u);
            asm volatile("s_waitcnt vmcnt(0)" ::: "memory");
        } else {
            XB_SPIN(xb_ld(&bar[XB_XGEN(b.x)]) == gen, bar);
            __builtin_amdgcn_fence(__ATOMIC_ACQUIRE, "agent");
            asm volatile("s_waitcnt vmcnt(0)" ::: "memory");
        }
    }
    __syncthreads();
}

constexpr int NWAVES = 8, NTHREADS = NWAVES * 64;
struct Frame {
    LAS unsigned char* lds;
    unsigned* ctl;
    int wave, vcu, G;
    unsigned char* ws;
    float* out;
};
enum { I_X = 0, I_POS, I_NMG, I_WIN, I_LRE, I_LIM, I_LDT, I_BRE, I_BIM, I_CRE, I_CIM, I_D, I_WGLU, I_BGLU, I_GNG, I_WBS5, I_WBRET, I_WOUT, I_NFG, I_RW, I_RB, I_W1, I_B1, I_W2, I_B2, I_NFIN };

__device__ __forceinline__ const float* inp(int i) {
    typedef const float* const __attribute__((address_space(4))) * kptr_t;
    kptr_t p = (kptr_t)__builtin_amdgcn_kernarg_segment_ptr(); asm volatile("" : "+s"(p)); return p[i];
}

__device__ __forceinline__ int otid() { int t = threadIdx.x; asm volatile("" : "+v"(t)); return t; }

__device__ __forceinline__ void sincos_d(double x, double& s, double& c) {
    const double n = __builtin_rint(x * 0.63661977236758134308);
    double r = __builtin_fma(-n, 1.57079632679489655800e+00, x);
    r = __builtin_fma(-n, 6.12323399573676603587e-17, r);
    const double r2 = r * r;
    double ps = -1.0 / 1307674368000.0;
    ps = __builtin_fma(ps, r2, 1.0 / 6227020800.0); ps = __builtin_fma(ps, r2, -1.0 / 39916800.0); ps = __builtin_fma(ps, r2, 1.0 / 362880.0);
    ps = __builtin_fma(ps, r2, -1.0 / 5040.0); ps = __builtin_fma(ps, r2, 1.0 / 120.0); ps = __builtin_fma(ps, r2, -1.0 / 6.0);
    const double sr = __builtin_fma(ps * r2, r, r);
    double pc = 1.0 / 20922789888000.0;
    pc = __builtin_fma(pc, r2, -1.0 / 87178291200.0); pc = __builtin_fma(pc, r2, 1.0 / 479001600.0); pc = __builtin_fma(pc, r2, -1.0 / 3628800.0);
    pc = __builtin_fma(pc, r2, 1.0 / 40320.0); pc = __builtin_fma(pc, r2, -1.0 / 720.0); pc = __builtin_fma(pc, r2, 1.0 / 24.0); pc = __builtin_fma(pc, r2, -0.5);
    const double cr = __builtin_fma(pc, r2, 1.0);
    const int q = ((int)n) & 3;
    s = (q == 0) ? sr : (q == 1) ? cr : (q == 2) ? -sr : -cr;
    c = (q == 0) ? cr : (q == 1) ? -sr : (q == 2) ? -cr : sr;
}
__device__ __forceinline__ double exp_d(double x) {
    const double k = __builtin_rint(x * 1.44269504088896338700);
    double r = __builtin_fma(-k, 6.93147180369123816490e-01, x);
    r = __builtin_fma(-k, 1.90821492927058770002e-10, r);
    double p = 1.0 / 6227020800.0;
    p = __builtin_fma(p, r, 1.0 / 479001600.0); p = __builtin_fma(p, r, 1.0 / 39916800.0); p = __builtin_fma(p, r, 1.0 / 3628800.0); p = __builtin_fma(p, r, 1.0 / 362880.0);
    p = __builtin_fma(p, r, 1.0 / 40320.0); p = __builtin_fma(p, r, 1.0 / 5040.0); p = __builtin_fma(p, r, 1.0 / 720.0); p = __builtin_fma(p, r, 1.0 / 120.0);
    p = __builtin_fma(p, r, 1.0 / 24.0); p = __builtin_fma(p, r, 1.0 / 6.0); p = __builtin_fma(p, r, 0.5); p = __builtin_fma(p, r, 1.0); p = __builtin_fma(p, r, 1.0);
    const long long bits = ((long long)((int)k + 1023)) << 52;
    return p * __builtin_bit_cast(double, bits);
}

__device__ __forceinline__ void p0_load_item(const float* W, int N, int k0, int n0, LAS float* scr, int lane) {
    const int kq = lane >> 3, n4 = (lane & 7) * 4; f32x4 v[8];
#pragma unroll
    for (int i = 0; i < 8; ++i) v[i] = __builtin_nontemporal_load((const f32x4*)(W + (size_t)(k0 + 8 * i + kq) * N + n0 + n4));
#pragma unroll
    for (int i = 0; i < 8; ++i) { LAS float* d = scr + (8 * i + kq) * 33 + n4; d[0] = v[i].x; d[1] = v[i].y; d[2] = v[i].z; d[3] = v[i].w; }
    LDS_WAIT(); asm volatile("" ::: "memory");
}
template <bool QKPERM>
__device__ __forceinline__ void p0_transpose_item(const float* W, int K, int N, bf16_t* WT, LAS float* scr, int item, int lane, int ldw) {
    const int nblk = N / 32, kb = item / nblk, nb = item % nblk, k0 = 64 * kb, n0 = 32 * nb;
    p0_load_item(W, N, k0, n0, scr, lane);
    const int c = lane & 7;
#pragma unroll
    for (int j = 0; j < 4; ++j) { const int n = (lane >> 3) + 8 * j; const LAS float* s = scr + (8 * c) * 33 + n;
        u32x4 o; o.x = pkbf(s[0 * 33], s[1 * 33]); o.y = pkbf(s[2 * 33], s[3 * 33]); o.z = pkbf(s[4 * 33], s[5 * 33]); o.w = pkbf(s[6 * 33], s[7 * 33]);
        int nd = n0 + n;
        if (QKPERM) { if (nd >= 512 && nd < 1536) { const int d = nd & 127; const int p = (d < 64) ? (8 * (d >> 2) + (d & 3)) : (8 * ((d - 64) >> 2) + 4 + (d & 3)); nd = (nd & ~127) + p; } }
        *(u32x4*)(WT + (size_t)nd * ldw + k0 + 8 * c) = o; }
    LDS_WAIT(); asm volatile("" ::: "memory");
}

template <int MODE>
__device__ __forceinline__ void p0_transpose_item_fp8(const float* W, int K, int N, unsigned char* WT, LAS float* scr, int item, int lane) {
    const int nblk = N / 32, kb = item / nblk, nb = item % nblk, k0 = 64 * kb, n0 = 32 * nb;
    p0_load_item(W, N, k0, n0, scr, lane);
    const int c = lane & 7;
#pragma unroll
    for (int j = 0; j < 4; ++j) { const int n = (lane >> 3) + 8 * j; const LAS float* s = scr + (8 * c) * 33 + n;
        u32x2 o; o.x = pkfp8x4(32.f * s[0 * 33], 32.f * s[1 * 33], 32.f * s[2 * 33], 32.f * s[3 * 33]); o.y = pkfp8x4(32.f * s[4 * 33], 32.f * s[5 * 33], 32.f * s[6 * 33], 32.f * s[7 * 33]);
        int nd = n0 + n; if (MODE == 1) { const int jj = nd >> 1; nd = 256 * (jj >> 7) + 128 * (nd & 1) + (jj & 127); }
        if (MODE == 2) nd -= 256 * IN_BF_TILES;
        if (MODE == 3) { const int L = nd & 255; nd = (nd & ~255) + 128 * ((L >> 3) & 1) + 32 * (L >> 6) + 8 * ((L >> 4) & 3) + (L & 7); }
        __builtin_nontemporal_store(o, (u32x2*)(WT + (size_t)nd * K + k0 + 8 * c)); }
    LDS_WAIT(); asm volatile("" ::: "memory");
}

__device__ __forceinline__ void p0_s5_group(Frame& F, int g, int part) {
    const int tid_o = otid();
    LAS float* PW = (LAS float*)(F.lds);
    LAS float* BP = (LAS float*)(F.lds + 17408);
    LAS float* CC = (LAS float*)(F.lds + 25600);
    LAS float* KD = (LAS float*)(F.lds + 33792);
    LAS float* FF = (LAS float*)(F.lds + 66560);
    const int tid = tid_o;
    if (tid < 64) {
        const int n = tid;
        const double lr = (double)inp(I_LRE)[g * 64 + n], li = (double)inp(I_LIM)[g * 64 + n], dt = exp_d((double)inp(I_LDT)[g]);
        const double mag = exp_d(lr * dt); double sn, cs; sincos_d(li * dt, sn, cs);
        const double ar = mag * cs, aim = mag * sn;
        const double nr = ar - 1.0, ni = aim, den = lr * lr + li * li;
        FF[2 * n] = (float)((nr * lr + ni * li) / den); FF[2 * n + 1] = (float)((ni * lr - nr * li) / den);
        double pr = 1.0, pi = 0.0;
        for (int d = 0; d <= 32; ++d) { PW[(d * 64 + n) * 2] = (float)pr; PW[(d * 64 + n) * 2 + 1] = (float)pi; const double t = pr * ar - pi * aim; pi = pr * aim + pi * ar; pr = t; }
        if (part == 0) { float* db = (float*)(F.ws + WS_DBUF) + (g * 64 + n) * 2; db[0] = PW[(32 * 64 + n) * 2]; db[1] = PW[(32 * 64 + n) * 2 + 1]; }
    }
    __syncthreads();
    for (int i = tid; i < 1024; i += NTHREADS) {
        const int n = i >> 4, c = i & 15; const float br = inp(I_BRE)[(g * 64 + n) * 16 + c], bi = inp(I_BIM)[(g * 64 + n) * 16 + c], fr = FF[2 * n], fi = FF[2 * n + 1];
        BP[i * 2] = fr * br - fi * bi; BP[i * 2 + 1] = fr * bi + fi * br;
        const int c2 = i >> 6, n2 = i & 63; CC[i * 2] = inp(I_CRE)[(g * 16 + c2) * 64 + n2]; CC[i * 2 + 1] = inp(I_CIM)[(g * 16 + c2) * 64 + n2];
    }
    __syncthreads();
    for (int i = tid; i < 2048; i += NTHREADS) {
        const int d = i >> 6, c = 4 * part + ((i >> 4) & 3), cp = i & 15; float a = 0.f;
        for (int n = 0; n < 64; ++n) {
            const f32x2 cv = *(const LAS f32x2*)(CC + (c * 64 + n) * 2), pv = *(const LAS f32x2*)(PW + (d * 64 + n) * 2), bv = *(const LAS f32x2*)(BP + (n * 16 + cp) * 2);
            const float tr = cv.x * pv.x - cv.y * pv.y, ti = cv.x * pv.y + cv.y * pv.x;
            a += tr * bv.x - ti * bv.y;
        }
        KD[i] = a;
    }
    __syncthreads();
    bf16_t* BtY = (bf16_t*)(F.ws + WS_BTY) + (size_t)g * 512 * 640;
    for (int id = tid; id < 128 * 80; id += NTHREADS) {
        const int rl = id / 80, ch = id % 80, t = rl >> 2, cl = rl & 3, c = 4 * part + cl, row = t * 16 + c; float v[8];
        if (ch < 64) { const int j = ch >> 1, cp0 = (ch & 1) * 8;
#pragma unroll
            for (int q = 0; q < 8; ++q) v[q] = (j <= t) ? KD[((t - j) * 4 + cl) * 16 + cp0 + q] : 0.f;
        } else { const int nn0 = (ch - 64) * 8;
#pragma unroll
            for (int q = 0; q < 8; ++q) { const int nn = nn0 + q, n = nn & 63; const f32x2 cv = *(const LAS f32x2*)(CC + (c * 64 + n) * 2), pv = *(const LAS f32x2*)(PW + ((t + 1) * 64 + n) * 2);
                v[q] = (nn < 64) ? (cv.x * pv.x - cv.y * pv.y) : -(cv.x * pv.y + cv.y * pv.x); }
        }
        u32x4 o; o.x = pkbf(v[0], v[1]); o.y = pkbf(v[2], v[3]); o.z = pkbf(v[4], v[5]); o.w = pkbf(v[6], v[7]);
        *(u32x4*)(BtY + (size_t)row * 640 + ch * 8) = o;
    }
    bf16_t* BtV = (bf16_t*)(F.ws + WS_BTV) + (size_t)g * 256 * 512;
    for (int id = tid; id < 64 * 64; id += NTHREADS) {
        const int row = 64 * part + (id >> 6), ch = id & 63, j = ch >> 1, cp0 = (ch & 1) * 8, n = row & 63; float v[8];
#pragma unroll
        for (int q = 0; q < 8; ++q) { const f32x2 pv = *(const LAS f32x2*)(PW + ((31 - j) * 64 + n) * 2), bv = *(const LAS f32x2*)(BP + (n * 16 + cp0 + q) * 2);
            v[q] = (row < 64) ? (pv.x * bv.x - pv.y * bv.y) : (row < 128) ? (pv.x * bv.y + pv.y * bv.x) : 0.f; }
        u32x4 o; o.x = pkbf(v[0], v[1]); o.y = pkbf(v[2], v[3]); o.z = pkbf(v[4], v[5]); o.w = pkbf(v[6], v[7]);
        *(u32x4*)(BtV + (size_t)row * 512 + ch * 8) = o;
    }
    __syncthreads();
}

__device__ __forceinline__ int p0_grab(unsigned* ctr, int n) { int v = 0; if ((otid() & 63) == 0) v = (int)__hip_atomic_fetch_add(ctr, (unsigned)n, __ATOMIC_RELAXED, __HIP_MEMORY_SCOPE_AGENT); return __builtin_amdgcn_readfirstlane(v); }
__device__ __forceinline__ void p0_prologue(Frame& F) {
    const int tid_o = otid(), lane_o = tid_o & 63;
    for (int it = blockIdx.x; it < 4 * S5G; it += F.G) p0_s5_group(F, it >> 2, it & 3);
    const int gw = F.vcu * NWAVES + F.wave, NGW = F.G * NWAVES;
    {
        const int* pos = (const int*)inp(I_POS); float* rope = (float*)(F.ws + WS_ROPE);
        const int gt = F.vcu * NTHREADS + tid_o, NGT = F.G * NTHREADS;
        for (int i = gt; i < T * 64; i += NGT) {
            const int tok = i >> 6, dh = i & 63;
            double f = 1.0; { double b = 0.86596432336006535; int e = dh; while (e) { if (e & 1) f *= b; b *= b; e >>= 1; } }
            double s, c; sincos_d((double)pos[tok] * f, s, c);
            rope[(size_t)tok * 128 + dh] = (float)c; rope[(size_t)tok * 128 + 64 + dh] = (float)s;
        }
    }
    {
        const float* gg = inp(I_NMG); f32x4 gv[4];
#pragma unroll
        for (int j = 0; j < 4; ++j) gv[j] = *((const f32x4*)gg + lane_o + 64 * j);
        for (int m = gw; m < T; m += NGW) {
            const f32x4* xr = (const f32x4*)(inp(I_X) + (size_t)m * DM) + lane_o; f32x4 v[4]; float s = 0.f;
#pragma unroll
            for (int j = 0; j < 4; ++j) { v[j] = __builtin_nontemporal_load(xr + 64 * j); s += (v[j].x * v[j].x + v[j].y * v[j].y) + (v[j].z * v[j].z + v[j].w * v[j].w); }
            const float rs = 1.0f / sqrtf(wave_sum(s) * (1.f / DM) + NORM_EPS);
            u32x2* o8 = (u32x2*)((bf16_t*)(F.ws + WS_H) + (size_t)m * DM) + lane_o;
            unsigned* o4 = (unsigned*)((unsigned char*)(F.ws + WS_H8) + (size_t)m * DM) + lane_o;
#pragma unroll
            for (int j = 0; j < 4; ++j) { const f32x4 hh = v[j] * rs * gv[j]; u32x2 o; o.x = pkbf(hh.x, hh.y); o.y = pkbf(hh.z, hh.w); o8[64 * j] = o; o4[64 * j] = pkfp8x4(hh.x, hh.y, hh.z, hh.w); }
        }
    }
    LAS float* scr = (LAS float*)(F.lds + F.wave * 16384);
    constexpr int I_IN = (DM / 64) * (INW / 32), I_GLU = (512 / 64) * (512 / 32), I_BS5 = (512 / 64) * (1024 / 32), I_SQ = (1024 / 64) * (1024 / 32);
    constexpr int I_E1 = (1024 / 64) * (2048 / 32), I_E2 = I_SQ;
    constexpr int NITEMS = I_IN + I_GLU + I_BS5 + 2 * I_SQ + NE * (I_E1 + I_E2), CHUNK = 8;
    unsigned* qctr = F.ctl + CW_QUEUE;
    int base = p0_grab(qctr, CHUNK);
    while (base < NITEMS) {
        const int nbase = p0_grab(qctr, CHUNK);
        const int end = (base + CHUNK < NITEMS) ? base + CHUNK : NITEMS;
        for (int it = base; it < end; ++it) {
            int r = it;
            if (r < NE * I_E1) { const int e = r / I_E1; p0_transpose_item_fp8<1>(inp(I_W1) + (size_t)e * 1024 * 2048, 1024, 2048, (unsigned char*)(F.ws + WS_W1) + (size_t)e * 2048 * 1024, scr, r % I_E1, lane_o); continue; } r -= NE * I_E1;
            if (r < NE * I_E2) { const int e = r / I_E2; p0_transpose_item_fp8<3>(inp(I_W2) + (size_t)e * 1024 * 1024, 1024, 1024, (unsigned char*)(F.ws + WS_W2) + (size_t)e * 1024 * 1024, scr, r % I_E2, lane_o); continue; } r -= NE * I_E2;
            if (r < I_IN) { if ((r % (INW / 32)) < 256 * IN_BF_TILES / 32) p0_transpose_item<true>(inp(I_WIN), DM, INW, (bf16_t*)(F.ws + WS_WIN), scr, r, lane_o, DM);
                            else p0_transpose_item_fp8<2>(inp(I_WIN), DM, INW, (unsigned char*)(F.ws + WS_WIN8), scr, r, lane_o); continue; } r -= I_IN;
            if (r < I_GLU) { p0_transpose_item<false>(inp(I_WGLU), 512, 512, (bf16_t*)(F.ws + WS_WGLU), scr, r, lane_o, 512); continue; } r -= I_GLU;
            if (r < I_BS5) { p0_transpose_item<false>(inp(I_WBS5), 512, 1024, (bf16_t*)(F.ws + WS_WCAT), scr, r, lane_o, 1536); continue; } r -= I_BS5;
            if (r < I_SQ) { p0_transpose_item<false>(inp(I_WBRET), 1024, 1024, (bf16_t*)(F.ws + WS_WCAT) + 512, scr, r, lane_o, 1536); continue; } r -= I_SQ;
            p0_transpose_item<false>(inp(I_WOUT), 1024, 1024, (bf16_t*)(F.ws + WS_WOUT), scr, r, lane_o, 1024);
        }
        base = nbase;
    }
}

typedef const f32x4 (&AccRef)[2][2][4][2];
struct Pre0 {};
struct Pre16 { f32x4 v[4]; };
#define EPI_ROWS(...) _Pragma("unroll") for (int ai = 0; ai < 2; ++ai) { _Pragma("unroll") for (int m = 0; m < 4; ++m) { const int rloc = ai * 128 + wr * 64 + m * 16 + fr; _Pragma("unroll") for (int bj = 0; bj < 2; ++bj) { const int cloc = bj * 128 + wc * 32 + 8 * fq; const f32x4 v0 = acc[ai][bj][m][0], v1 = acc[ai][bj][m][1]; __VA_ARGS__ } } asm volatile("" ::: "memory"); }

__device__ __forceinline__ float l2gamma(int h) { return h == 0 ? -0.04580368961312479f : h == 1 ? -0.02272007650008353f : h == 2 ? -0.011315313227834146f : -0.005646563141142063f; }

template <bool GATES> struct EpiInProj {
    static constexpr bool PERM = true, FP8 = GATES;
    unsigned char* ws;
    typedef Pre0 Pre; __device__ __forceinline__ Pre prefetch(const Unit&, int, int, int, int) const { return Pre(); }
    __device__ __forceinline__ void operator()(AccRef acc, const Unit& u, int wr, int wc, int fr, int fq, const Pre&) const {
        const int ct = u.pn + (GATES ? IN_BF_TILES : 0); constexpr int LO = GATES ? IN_BF_TILES : 0, HI = GATES ? 22 : IN_BF_TILES;
        if (LO < 2 && ct < 2) {
            bf16_t* AS5 = (bf16_t*)(ws + WS_AS5);
            EPI_ROWS({ const int row = u.pm * 256 + rloc, col = ct * 256 + cloc, g = col >> 4, c0 = col & 15, b = row >> 13, t = row & 8191;
                u32x4 o; o.x = pkbf(v0[0], v0[1]); o.y = pkbf(v0[2], v0[3]); o.z = pkbf(v1[0], v1[1]); o.w = pkbf(v1[2], v1[3]);
                *(u32x4*)(AS5 + ((size_t)(g * 1024 + b * 256 + (t >> 5)) * 640 + (t & 31) * 16 + c0)) = o; })
        } else if (LO < 6 && HI > 2 && ct < 6) {
            const bool isk = ct >= 4; const float* rope = (const float*)(ws + WS_ROPE);
            bf16_t* QK = (bf16_t*)(ws + (isk ? WS_K : WS_Q));
            EPI_ROWS({ const int row = u.pm * 256 + rloc, hh = ((ct & 1) << 1) + bj, p0 = wc * 32 + 8 * fq, dh0 = p0 >> 1;
                const f32x4 cs = *(const f32x4*)(rope + (size_t)row * 128 + dh0), sn = *(const f32x4*)(rope + (size_t)row * 128 + 64 + dh0);
                const float e = (float)((row & 127) + 1), lg = l2gamma(hh);
                const float sc = isk ? __builtin_amdgcn_exp2f(-lg * e) * 0.08838834764831845f : __builtin_amdgcn_exp2f(lg * e);
                const f32x4 o1 = (v0 * cs - v1 * sn) * sc, o2 = (v1 * cs + v0 * sn) * sc;
                u32x4 o; o.x = pkbf(o1[0], o1[1]); o.y = pkbf(o1[2], o1[3]); o.z = pkbf(o2[0], o2[1]); o.w = pkbf(o2[2], o2[3]);
                *(u32x4*)(QK + (size_t)row * 512 + hh * 128 + p0) = o; })
        } else if (LO < 10 && HI > 6 && ct < 10) {
            bf16_t* V = (bf16_t*)(ws + WS_V);
            EPI_ROWS({ const int row = u.pm * 256 + rloc, col = (ct - 6) * 256 + cloc;
                u32x4 o; o.x = pkbf(v0[0], v0[1]); o.y = pkbf(v0[2], v0[3]); o.z = pkbf(v1[0], v1[1]); o.w = pkbf(v1[2], v1[3]);
                *(u32x4*)(V + (size_t)row * 1024 + col) = o; })
        } else if (HI > 10) {
            const bool is_silu = ct < 14; bf16_t* SG = (bf16_t*)(ws + (ct < 14 ? WS_GS : ct < 18 ? WS_SA : WS_SB)); const int cb = ((ct - 10) & 3) * 256;
            if (is_silu) {
                EPI_ROWS({ const int row = u.pm * 256 + rloc, col = cb + cloc; f32x4 a0 = v0, a1 = v1; asm volatile("" : "+v"(a0), "+v"(a1));
                    const f32x2 x0 = {a0[0], a0[1]}, x1 = {a0[2], a0[3]}, x2 = {a1[0], a1[1]}, x3 = {a1[2], a1[3]};
                    const f32x2 y0 = x0 * fsigmoid2(x0), y1 = x1 * fsigmoid2(x1), y2 = x2 * fsigmoid2(x2), y3 = x3 * fsigmoid2(x3);
                    u32x4 o; o.x = pkbf(y0.x, y0.y); o.y = pkbf(y1.x, y1.y); o.z = pkbf(y2.x, y2.y); o.w = pkbf(y3.x, y3.y);
                    __builtin_nontemporal_store(o, (u32x4*)(SG + (size_t)row * 1024 + col)); })
            } else {
                EPI_ROWS({ const int row = u.pm * 256 + rloc, col = cb + cloc; f32x4 a0 = v0, a1 = v1; asm volatile("" : "+v"(a0), "+v"(a1));
                    const f32x2 y0 = fsigmoid2(f32x2{a0[0], a0[1]}), y1 = fsigmoid2(f32x2{a0[2], a0[3]}), y2 = fsigmoid2(f32x2{a1[0], a1[1]}), y3 = fsigmoid2(f32x2{a1[2], a1[3]});
                    u32x4 o; o.x = pkbf(y0.x, y0.y); o.y = pkbf(y1.x, y1.y); o.z = pkbf(y2.x, y2.y); o.w = pkbf(y3.x, y3.y);
                    __builtin_nontemporal_store(o, (u32x4*)(SG + (size_t)row * 1024 + col)); })
            }
        }
    }
};

struct EpiS5V {
    static constexpr bool PERM = false, FP8 = false;
    float* VB;
    typedef Pre0 Pre; __device__ __forceinline__ Pre prefetch(const Unit&, int, int, int, int) const { return Pre(); }
    __device__ __forceinline__ void operator()(AccRef acc, const Unit& u, int wr, int wc, int fr, int fq, const Pre&) const {
#pragma unroll
        for (int ai = 0; ai < 2; ++ai)
#pragma unroll
            for (int m = 0; m < 4; ++m) { const int r = u.pm * 256 + ai * 128 + wr * 64 + m * 16 + fr; float* rp = VB + ((size_t)(u.aux * 1024 + r)) * 128 + wc * 32 + 4 * fq;
#pragma unroll
                for (int n = 0; n < 2; ++n) *(f32x4*)(rp + n * 16) = acc[ai][0][m][n]; }
    }
};

struct EpiS5Y {
    static constexpr bool PERM = true, FP8 = false;
    const bf16_t* AS5; bf16_t* Z; const float* dsk;
    typedef Pre0 Pre; __device__ __forceinline__ Pre prefetch(const Unit&, int, int, int, int) const { return Pre(); }
    __device__ __forceinline__ void operator()(AccRef acc, const Unit& u, int wr, int wc, int fr, int fq, const Pre&) const {
        const int g = u.aux;
        EPI_ROWS({ const int r = u.pm * 256 + rloc, col = u.pn * 256 + cloc, b = r >> 8, ch = r & 255, tl = col >> 4, c0 = col & 15, tok = b * 8192 + ch * 32 + tl;
            const u32x4 uu = *(const u32x4*)(AS5 + ((size_t)(g * 1024 + r)) * 640 + col);
            const f32x4 d0 = *(const f32x4*)(dsk + g * 16 + c0), d1 = *(const f32x4*)(dsk + g * 16 + c0 + 4);
            f32x2 y[4] = { f32x2{v0[0], v0[1]} + f32x2{d0[0], d0[1]} * f32x2{bflo(uu.x), bfhi(uu.x)}, f32x2{v0[2], v0[3]} + f32x2{d0[2], d0[3]} * f32x2{bflo(uu.y), bfhi(uu.y)},
                           f32x2{v1[0], v1[1]} + f32x2{d1[0], d1[1]} * f32x2{bflo(uu.z), bfhi(uu.z)}, f32x2{v1[2], v1[3]} + f32x2{d1[2], d1[3]} * f32x2{bflo(uu.w), bfhi(uu.w)} };
            _Pragma("unroll") for (int q = 0; q < 4; ++q) { const f32x2 a = (y[q] + (y[q] * y[q]) * y[q] * 0.044715f) * 0.7978845608028654f; y[q] = y[q] * fsigmoid2(a * 2.0f); }
            u32x4 o; o.x = pkbf(y[0].x, y[0].y); o.y = pkbf(y[1].x, y[1].y); o.z = pkbf(y[2].x, y[2].y); o.w = pkbf(y[3].x, y[3].y);
            *(u32x4*)(Z + (size_t)tok * 512 + g * 16 + c0) = o; })
    }
};

struct EpiGlu {
    static constexpr bool PERM = true, FP8 = false;
    const bf16_t* Z; bf16_t* Y; const float* bg;
    typedef Pre0 Pre; __device__ __forceinline__ Pre prefetch(const Unit&, int, int, int, int) const { return Pre(); }
    __device__ __forceinline__ void operator()(AccRef acc, const Unit& u, int wr, int wc, int fr, int fq, const Pre&) const {
        EPI_ROWS({ const int row = u.pm * 256 + rloc, col = u.pn * 256 + cloc;
            const u32x4 zz = __builtin_nontemporal_load((const u32x4*)(Z + (size_t)row * 512 + col)); const f32x4 b0 = *(const f32x4*)(bg + col), b1 = *(const f32x4*)(bg + col + 4);
            const f32x2 y0 = f32x2{bflo(zz.x), bfhi(zz.x)} * fsigmoid2(f32x2{v0[0], v0[1]} + f32x2{b0[0], b0[1]}), y1 = f32x2{bflo(zz.y), bfhi(zz.y)} * fsigmoid2(f32x2{v0[2], v0[3]} + f32x2{b0[2], b0[3]});
            const f32x2 y2 = f32x2{bflo(zz.z), bfhi(zz.z)} * fsigmoid2(f32x2{v1[0], v1[1]} + f32x2{b1[0], b1[1]}), y3 = f32x2{bflo(zz.w), bfhi(zz.w)} * fsigmoid2(f32x2{v1[2], v1[3]} + f32x2{b1[2], b1[3]});
            u32x4 o; o.x = pkbf(y0.x, y0.y); o.y = pkbf(y1.x, y1.y); o.z = pkbf(y2.x, y2.y); o.w = pkbf(y3.x, y3.y);
            *(u32x4*)(Y + (size_t)row * 512 + col) = o; })
    }
};

struct EpiChain {
    static constexpr bool PERM = true, FP8 = false;
    const bf16_t* SA; const bf16_t* SB; bf16_t* O;
    typedef Pre0 Pre; __device__ __forceinline__ Pre prefetch(const Unit&, int, int, int, int) const { return Pre(); }
    __device__ __forceinline__ void operator()(f32x4 (&acc)[2][2][4][2], const Unit& u, int wr, int wc, int fr, int fq, const Pre&) const {
        if (u.seg == 0) {
#pragma unroll
            for (int ai = 0; ai < 2; ++ai) {
#pragma unroll
                for (int m = 0; m < 4; ++m)
#pragma unroll
                    for (int bj = 0; bj < 2; ++bj) { const size_t off = (size_t)(u.pm * 256 + ai * 128 + wr * 64 + m * 16 + fr) * 1024 + u.pn * 256 + bj * 128 + wc * 32 + 8 * fq;
                        const u32x4 a = __builtin_nontemporal_load((const u32x4*)(SA + off)); const u32x4 b = *(const u32x4*)(SB + off);
                        f32x4& v0 = acc[ai][bj][m][0]; f32x4& v1 = acc[ai][bj][m][1];
                        v0[0] *= bflo(a.x) * __builtin_amdgcn_rcpf(fmaxf(bflo(b.x), 1e-30f)); v0[1] *= bfhi(a.x) * __builtin_amdgcn_rcpf(fmaxf(bfhi(b.x), 1e-30f)); v0[2] *= bflo(a.y) * __builtin_amdgcn_rcpf(fmaxf(bflo(b.y), 1e-30f)); v0[3] *= bfhi(a.y) * __builtin_amdgcn_rcpf(fmaxf(bfhi(b.y), 1e-30f));
                        v1[0] *= bflo(a.z) * __builtin_amdgcn_rcpf(fmaxf(bflo(b.z), 1e-30f)); v1[1] *= bfhi(a.z) * __builtin_amdgcn_rcpf(fmaxf(bfhi(b.z), 1e-30f)); v1[2] *= bflo(a.w) * __builtin_amdgcn_rcpf(fmaxf(bflo(b.w), 1e-30f)); v1[3] *= bfhi(a.w) * __builtin_amdgcn_rcpf(fmaxf(bfhi(b.w), 1e-30f)); }
                asm volatile("" ::: "memory"); }
        } else {
            EPI_ROWS({ const size_t off = (size_t)(u.pm * 256 + rloc) * 1024 + u.pn * 256 + cloc;
                const u32x4 s = __builtin_nontemporal_load((const u32x4*)(SB + off));
                u32x4 o; o.x = pkbf(v0[0] * bflo(s.x), v0[1] * bfhi(s.x)); o.y = pkbf(v0[2] * bflo(s.y), v0[3] * bfhi(s.y)); o.z = pkbf(v1[0] * bflo(s.z), v1[1] * bfhi(s.z)); o.w = pkbf(v1[2] * bflo(s.w), v1[3] * bfhi(s.w));
                *(u32x4*)(O + off) = o; })
        }
    }
};

struct EpiResid {
    static constexpr bool PERM = true, FP8 = false;
    const float* X; bf16_t* O; float* RSS;
    typedef Pre0 Pre; __device__ __forceinline__ Pre prefetch(const Unit&, int, int, int, int) const { return Pre(); }
    __device__ __forceinline__ void operator()(AccRef acc, const Unit& u, int wr, int wc, int fr, int fq, const Pre&) const {
#pragma unroll
        for (int ai = 0; ai < 2; ++ai)
#pragma unroll
            for (int m = 0; m < 4; ++m) { const int row = u.pm * 256 + ai * 128 + wr * 64 + m * 16 + fr; const size_t off = (size_t)row * 1024 + u.pn * 256 + wc * 32 + 8 * fq; float ss = 0.f;
#pragma unroll
                for (int bj = 0; bj < 2; ++bj) { const f32x4 o0 = __builtin_nontemporal_load((const f32x4*)(X + off + bj * 128)) + acc[ai][bj][m][0], o1 = __builtin_nontemporal_load((const f32x4*)(X + off + bj * 128 + 4)) + acc[ai][bj][m][1];
                    u32x4 o; o.x = pkbf(o0[0], o0[1]); o.y = pkbf(o0[2], o0[3]); o.z = pkbf(o1[0], o1[1]); o.w = pkbf(o1[2], o1[3]); *(u32x4*)(O + off + bj * 128) = o;
                    ss += ((o0[0] * o0[0] + o0[1] * o0[1]) + (o0[2] * o0[2] + o0[3] * o0[3])) + ((o1[0] * o1[0] + o1[1] * o1[1]) + (o1[2] * o1[2] + o1[3] * o1[3])); }
                ss += __shfl_xor(ss, 16); ss += __shfl_xor(ss, 32);
                if (fq == 0) RSS[(size_t)row * 16 + u.pn * 4 + wc] = ss;
                if (m == 3) asm volatile("" ::: "memory"); }
    }
};

struct EpiSwiglu {
    static constexpr bool PERM = true, FP8 = true;
    const float* b1; unsigned char* ACT;
    typedef Pre16 Pre;
    __device__ __forceinline__ Pre prefetch(const Unit& u, int wr, int wc, int fr, int fq) const { const float* bb = b1 + (size_t)u.aux * 2048 + 2 * (u.pn * 128 + wc * 32 + 8 * fq); Pre p;
        p.v[0] = *(const f32x4*)(bb); p.v[1] = *(const f32x4*)(bb + 4); p.v[2] = *(const f32x4*)(bb + 8); p.v[3] = *(const f32x4*)(bb + 12); return p; }
    __device__ __forceinline__ void operator()(AccRef acc, const Unit& u, int wr, int wc, int fr, int fq, const Pre& pre) const {
        const int j0 = u.pn * 128 + wc * 32 + 8 * fq;
        const f32x4 q0 = pre.v[0], q1 = pre.v[1], q2 = pre.v[2], q3 = pre.v[3];
        const f32x2 bg[4] = {{q0[0], q0[2]}, {q1[0], q1[2]}, {q2[0], q2[2]}, {q3[0], q3[2]}};
        const f32x2 bl[4] = {f32x2{q0[1], q0[3]} + 1.f, f32x2{q1[1], q1[3]} + 1.f, f32x2{q2[1], q2[3]} + 1.f, f32x2{q3[1], q3[3]} + 1.f};
#pragma unroll
        for (int ai = 0; ai < 2; ++ai)
#pragma unroll
            for (int m = 0; m < 4; ++m) { const int row = u.pm * 256 + ai * 128 + wr * 64 + m * 16 + fr;
                const f32x4 g0 = acc[ai][0][m][0], g1 = acc[ai][0][m][1], l0 = acc[ai][1][m][0], l1 = acc[ai][1][m][1];
                const f32x2 gg[4] = {{g0[0], g0[1]}, {g0[2], g0[3]}, {g1[0], g1[1]}, {g1[2], g1[3]}}, ll[4] = {{l0[0], l0[1]}, {l0[2], l0[3]}, {l1[0], l1[1]}, {l1[2], l1[3]}}; f32x2 r[4];
#pragma unroll
                for (int q = 0; q < 4; ++q) { f32x2 xg = gg[q] + bg[q], xl = ll[q] + bl[q];
                    xg.x = __builtin_amdgcn_fmed3f(xg.x, -40.f, 7.f); xg.y = __builtin_amdgcn_fmed3f(xg.y, -40.f, 7.f);
                    xl.x = __builtin_amdgcn_fmed3f(xl.x, -6.f, 8.f); xl.y = __builtin_amdgcn_fmed3f(xl.y, -6.f, 8.f);
                    const f32x2 t = xg * -2.4554669595930157f;
                    const f32x2 d = f32x2{__builtin_amdgcn_exp2f(t.x), __builtin_amdgcn_exp2f(t.y)} + 1.0f;
                    const float rp = __builtin_amdgcn_rcpf(d.x * d.y);
                    r[q] = (xg * (f32x2{d.y, d.x} * rp)) * xl; }
                u32x2 o; o.x = pkfp8x4(r[0].x, r[0].y, r[1].x, r[1].y); o.y = pkfp8x4(r[2].x, r[2].y, r[3].x, r[3].y);
                *(u32x2*)(ACT + (size_t)row * 1024 + j0) = o; }
    }
};
struct EpiExpOut {
    static constexpr bool PERM = true, FP8 = true; static constexpr int NST = 0;
    const float* b2; unsigned char* YK;
    typedef Pre16 Pre;
    __device__ __forceinline__ Pre prefetch(const Unit& u, int wr, int wc, int fr, int fq) const { const float* bb = b2 + (size_t)u.aux * 1024 + u.pn * 256 + 64 * wc + 16 * fq; Pre p;
        p.v[0] = *(const f32x4*)(bb); p.v[1] = *(const f32x4*)(bb + 4); p.v[2] = *(const f32x4*)(bb + 8); p.v[3] = *(const f32x4*)(bb + 12); return p; }
    __device__ __forceinline__ void operator()(AccRef acc, const Unit& u, int wr, int wc, int fr, int fq, const Pre& pre) const {
        const int lb = u.pn * 256 + 64 * wc + 16 * fq;
        const f32x4 b0 = pre.v[0], b1 = pre.v[1], b2v = pre.v[2], b3 = pre.v[3];
#pragma unroll
        for (int r = 0; r < 8; ++r) { const int ai = r >> 2, m = r & 3, row = u.pm * 256 + ai * 128 + wr * 64 + m * 16 + fr;
            const f32x4 a0 = acc[ai][0][m][0] + b0, a1 = acc[ai][0][m][1] + b1, a2 = acc[ai][1][m][0] + b2v, a3 = acc[ai][1][m][1] + b3;
            u32x4 o; o.x = pkfp8x4(a0[0], a0[1], a0[2], a0[3]); o.y = pkfp8x4(a1[0], a1[1], a1[2], a1[3]); o.z = pkfp8x4(a2[0], a2[1], a2[2], a2[3]); o.w = pkfp8x4(a3[0], a3[1], a3[2], a3[3]);
            *(u32x4*)(YK + (size_t)row * 1024 + lb) = o; }
    }
};

constexpr int RSTR = 272;
__device__ __forceinline__ bf16x8 lds_frag(const LAS unsigned char* base, int row0, int k0, int fr, int fq) { return *(const LAS bf16x8*)(base + (row0 + fr) * RSTR + (k0 + 8 * fq) * 2); }

typedef short s16x4 __attribute__((ext_vector_type(4)));
__device__ __forceinline__ bf16x8 tr_frag(const LAS unsigned char* p, int rowstride) {
    const s16x4 lo = __builtin_bit_cast(s16x4, __builtin_amdgcn_ds_read_tr16_b64_v4i16((LAS s16x4*)(p)));
    const s16x4 hi = __builtin_bit_cast(s16x4, __builtin_amdgcn_ds_read_tr16_b64_v4i16((LAS s16x4*)(p + 16 * rowstride)));
    return (bf16x8){lo[0], lo[1], lo[2], lo[3], hi[0], hi[1], hi[2], hi[3]};
}
constexpr int KSTR_A = 288, VSTR = 544;

__device__ __forceinline__ void ret_pass_a(Frame& F) {
    const int tid_o = otid(), lane_o = tid_o & 63;
    const int tid = tid_o, wid = F.wave, lane = lane_o, fr = lane & 15, fq = lane >> 4;
    const bf16_t* Kb = (const bf16_t*)(F.ws + WS_K); const bf16_t* V = (const bf16_t*)(F.ws + WS_V); bf16_t* KV = (bf16_t*)(F.ws + WS_KV);
    LAS unsigned char* sK = F.lds; LAS unsigned char* sV = F.lds + 128 * KSTR_A;
    const int trow = 4 * fq + (fr >> 2), tcol = 4 * (fr & 3);
    constexpr int NIT = 16 * (RNC - 1);
    int it = blockIdx.x; if (it >= NIT) return;
    u32x4 kr[4], vr[8];
#define RA_LOAD(item) do { const int bh_ = (item) / (RNC - 1), c_ = (item) % (RNC - 1), tok_ = (bh_ >> 2) * 8192 + c_ * 128, h_ = bh_ & 3; \
        _Pragma("unroll") for (int i = 0; i < 4; ++i) { const int id = tid + NTHREADS * i; kr[i] = *(const u32x4*)(Kb + ((size_t)(tok_ + (id >> 4))) * 512 + h_ * 128 + (id & 15) * 8); } \
        _Pragma("unroll") for (int i = 0; i < 8; ++i) { const int id = tid + NTHREADS * i; vr[i] = *(const u32x4*)(V + ((size_t)(tok_ + (id >> 5))) * 1024 + h_ * 256 + (id & 31) * 8); } } while (0)
    RA_LOAD(it);
    for (;;) {
        const int bh = it / (RNC - 1), c = it % (RNC - 1);
#pragma unroll
        for (int i = 0; i < 4; ++i) { const int id = tid + NTHREADS * i; *(LAS u32x4*)(sK + (id >> 4) * KSTR_A + (id & 15) * 16) = kr[i]; }
#pragma unroll
        for (int i = 0; i < 8; ++i) { const int id = tid + NTHREADS * i; *(LAS u32x4*)(sV + (id >> 5) * VSTR + (id & 31) * 16) = vr[i]; }
        LDS_BARRIER();
        const int nit = it + F.G; const bool has = nit < NIT;
        if (has) RA_LOAD(nit);
        f32x4 acc[2][8];
#pragma unroll
        for (int mt = 0; mt < 2; ++mt)
#pragma unroll
            for (int nt = 0; nt < 8; ++nt) acc[mt][nt] = (f32x4){0.f, 0.f, 0.f, 0.f};
#pragma unroll
        for (int ks = 0; ks < 4; ++ks) {
            bf16x8 vf[2];
#pragma unroll
            for (int mt = 0; mt < 2; ++mt) vf[mt] = tr_frag(sV + (ks * 32 + trow) * VSTR + (wid * 32 + mt * 16 + tcol) * 2, VSTR);
#pragma unroll
            for (int nt = 0; nt < 8; ++nt) { const bf16x8 kf = tr_frag(sK + (ks * 32 + trow) * KSTR_A + (nt * 16 + tcol) * 2, KSTR_A);
#pragma unroll
                for (int mt = 0; mt < 2; ++mt) acc[mt][nt] = __builtin_amdgcn_mfma_f32_16x16x32_bf16(kf, vf[mt], acc[mt][nt], 0, 0, 0); }
        }
        LDS_BARRIER();
        LAS unsigned char* stg = sV + wid * (32 * 272);
#pragma unroll
        for (int mt = 0; mt < 2; ++mt)
#pragma unroll
            for (int nt = 0; nt < 8; ++nt) { u32x2 w; w.x = pkbf(acc[mt][nt][0], acc[mt][nt][1]); w.y = pkbf(acc[mt][nt][2], acc[mt][nt][3]); *(LAS u32x2*)(stg + (mt * 16 + fr) * 272 + (nt * 16 + 4 * fq) * 2) = w; }
        LDS_WAIT(); asm volatile("" ::: "memory");
        { bf16_t* o = KV + ((size_t)(bh * RNC + c)) * 32768 + (size_t)(wid * 32) * 128; int tg = lane; asm volatile("" : "+v"(tg));
#pragma unroll
          for (int i2 = 0; i2 < 8; ++i2) { const int id = tg + 64 * i2; *(u32x4*)(o + (id >> 4) * 128 + (id & 15) * 8) = *(const LAS u32x4*)(stg + (id >> 4) * 272 + (id & 15) * 16); } }
        LDS_BARRIER();
        if (!has) break;
        it = nit;
    }
#undef RA_LOAD
}

__device__ __forceinline__ void ret_pass_b(Frame& F) {
    const int tid_o = otid();
    const bf16_t* KV = (const bf16_t*)(F.ws + WS_KV); bf16_t* ST = (bf16_t*)(F.ws + WS_ST);
    if (tid_o >= 256) return;
    const bool g256 = (F.G == 256); const int nmine = g256 ? (F.vcu < 128 ? 192 : 320) : 256, base = g256 ? (F.vcu < 128 ? F.vcu * 192 : 128 * 192 + (F.vcu - 128) * 320) : F.vcu * 256, step = g256 ? 65536 : F.G * 256;
    for (int j = tid_o; j < nmine; j += 256) for (int i = base + j; i < 16 * 4096; i += step) {
        const int bh = i >> 12, e8 = i & 4095, h = bh & 3; const float gC = __builtin_amdgcn_exp2f(128.0f * l2gamma(h));
        float s[8];
#pragma unroll
        for (int q = 0; q < 8; ++q) s[q] = 0.f;
        const bf16_t* kp = KV + (size_t)bh * RNC * 32768 + e8 * 8; bf16_t* sp = ST + (size_t)bh * RNC * 32768 + e8 * 8;
#pragma unroll 8
        for (int c = 0; c < RNC; ++c) {
            u32x4 o; o.x = pkbf(s[0], s[1]); o.y = pkbf(s[2], s[3]); o.z = pkbf(s[4], s[5]); o.w = pkbf(s[6], s[7]); *(u32x4*)(sp + (size_t)c * 32768) = o;
            if (c < RNC - 1) { const u32x4 kv = __builtin_nontemporal_load((const u32x4*)(kp + (size_t)c * 32768));
                s[0] = (s[0] + bflo(kv.x)) * gC; s[1] = (s[1] + bfhi(kv.x)) * gC; s[2] = (s[2] + bflo(kv.y)) * gC; s[3] = (s[3] + bfhi(kv.y)) * gC;
                s[4] = (s[4] + bflo(kv.z)) * gC; s[5] = (s[5] + bfhi(kv.z)) * gC; s[6] = (s[6] + bflo(kv.w)) * gC; s[7] = (s[7] + bfhi(kv.w)) * gC; }
        }
    }
}

__device__ __forceinline__ void ret_pass_c(Frame& F) {
    const int tid_o = otid(), lane_o = tid_o & 63;
    const int tid = tid_o, wid = F.wave, lane = lane_o, fr = lane & 15, fq = lane >> 4;
    const bf16_t* Q = (const bf16_t*)(F.ws + WS_Q); const bf16_t* Kb = (const bf16_t*)(F.ws + WS_K); const bf16_t* V = (const bf16_t*)(F.ws + WS_V);
    const bf16_t* ST = (const bf16_t*)(F.ws + WS_ST); const bf16_t* GS = (const bf16_t*)(F.ws + WS_GS); bf16_t* RETG = (bf16_t*)(F.ws + WS_RETG);
    const float* gng = inp(I_GNG);
    LAS unsigned char* sK = F.lds;
    LAS unsigned char* sV = F.lds + 128 * RSTR;
    const int trow = 4 * fq + (fr >> 2), tcol = 4 * (fr & 3);
    constexpr int NIT = 16 * RNC;
    int it = blockIdx.x; if (it >= NIT) return;
    u32x4 kr[4], vr[8]; bf16x8 qf[4], qn[4];
#define RC_LOAD(item, qdst) do { int tl = tid; asm volatile("" : "+v"(tl)); const int bh_ = (item) / RNC, c_ = (item) % RNC, tok_ = (bh_ >> 2) * 8192 + c_ * 128, h_ = bh_ & 3; \
        _Pragma("unroll") for (int i = 0; i < 4; ++i) { const int id = tl + NTHREADS * i; kr[i] = __builtin_nontemporal_load((const u32x4*)(Kb + ((size_t)(tok_ + (id >> 4))) * 512 + h_ * 128 + (id & 15) * 8)); } \
        _Pragma("unroll") for (int i = 0; i < 8; ++i) { const int id = tl + NTHREADS * i; vr[i] = __builtin_nontemporal_load((const u32x4*)(V + ((size_t)(tok_ + (id >> 5))) * 1024 + h_ * 256 + (id & 31) * 8)); } \
        _Pragma("unroll") for (int ks = 0; ks < 4; ++ks) qdst[ks] = __builtin_nontemporal_load((const bf16x8*)(Q + ((size_t)(tok_ + wid * 16 + fr)) * 512 + h_ * 128 + ks * 32 + fq * 8)); } while (0)
    RC_LOAD(it, qf);
    for (;;) {
        const int bh = it / RNC, c = it % RNC, b = bh >> 2, h = bh & 3; const int tok0 = b * 8192 + c * 128;
        int tw = tid; asm volatile("" : "+v"(tw));
#pragma unroll
        for (int i = 0; i < 4; ++i) { const int id = tw + NTHREADS * i; *(LAS u32x4*)(sK + (id >> 4) * RSTR + (id & 15) * 16) = kr[i]; }
#pragma unroll
        for (int i = 0; i < 8; ++i) { const int id = tw + NTHREADS * i; *(LAS u32x4*)(sV + (id >> 5) * VSTR + (id & 31) * 16) = vr[i]; }
        LDS_BARRIER();
        u32x4 sr[8]; int ts = tid; asm volatile("" : "+v"(ts));
#pragma unroll
        for (int i = 0; i < 8; ++i) { const int id = ts + NTHREADS * i; sr[i] = __builtin_nontemporal_load((const u32x4*)(ST + ((size_t)(bh * RNC + c)) * 32768 + (id >> 4) * 128 + (id & 15) * 8)); }
        f32x4 sc[8];
#pragma unroll
        for (int nt = 0; nt < 8; ++nt) { sc[nt] = (f32x4){0.f, 0.f, 0.f, 0.f};
            if (nt <= wid) {
#pragma unroll
                for (int ks = 0; ks < 4; ++ks) sc[nt] = __builtin_amdgcn_mfma_f32_16x16x32_bf16(lds_frag(sK, nt * 16, ks * 32, fr, fq), qf[ks], sc[nt], 0, 0, 0);
                if (nt == wid) {
#pragma unroll
                    for (int r = 0; r < 4; ++r) if (4 * fq + r > fr) sc[nt][r] = 0.f;
                } } }
        LDS_BARRIER();
        LAS unsigned char* sP = sK + wid * 16 * RSTR;
#pragma unroll
        for (int nt = 0; nt < 8; ++nt) { u32x2 o; o.x = pkbf(sc[nt][0], sc[nt][1]); o.y = pkbf(sc[nt][2], sc[nt][3]); *(LAS u32x2*)(sP + fr * RSTR + (nt * 16 + 4 * fq) * 2) = o; }
        LDS_WAIT(); asm volatile("" ::: "memory");
        bf16x8 pf[4];
#pragma unroll
        for (int ks = 0; ks < 4; ++ks) { const u32x2 p0 = *(const LAS u32x2*)(sP + fr * RSTR + (ks * 32 + 4 * fq) * 2), p1 = *(const LAS u32x2*)(sP + fr * RSTR + (ks * 32 + 16 + 4 * fq) * 2);
            u32x4 pp; pp.x = p0.x; pp.y = p0.y; pp.z = p1.x; pp.w = p1.y; pf[ks] = __builtin_bit_cast(bf16x8, pp); }
        f32x4 acc[16];
#pragma unroll
        for (int nt = 0; nt < 16; ++nt) acc[nt] = (f32x4){0.f, 0.f, 0.f, 0.f};
#pragma unroll
        for (int ks = 0; ks < 4; ++ks) if (2 * ks <= wid) {
#pragma unroll
            for (int nt = 0; nt < 16; ++nt) { acc[nt] = __builtin_amdgcn_mfma_f32_16x16x32_bf16(tr_frag(sV + (ks * 32 + trow) * VSTR + (nt * 16 + tcol) * 2, VSTR), pf[ks], acc[nt], 0, 0, 0); } }
        LDS_BARRIER();
#pragma unroll
        for (int i = 0; i < 8; ++i) { const int id = ts + NTHREADS * i; *(LAS u32x4*)(sV + (id >> 4) * RSTR + (id & 15) * 16) = sr[i]; }
        u32x4 gsr[8]; int tg = lane; asm volatile("" : "+v"(tg));
#pragma unroll
        for (int i2 = 0; i2 < 8; ++i2) { const int id = tg + 64 * i2; gsr[i2] = __builtin_nontemporal_load((const u32x4*)(GS + (size_t)(tok0 + wid * 16 + (id >> 5)) * 1024 + h * 256 + (id & 31) * 8)); }
        const int nit = it + F.G; const bool has = nit < NIT;
        if (has) RC_LOAD(nit, qn);
        LDS_BARRIER();
#pragma unroll
        for (int ks = 0; ks < 4; ++ks)
#pragma unroll
            for (int nt = 0; nt < 16; ++nt) { acc[nt] = __builtin_amdgcn_mfma_f32_16x16x32_bf16(lds_frag(sV, nt * 16, ks * 32, fr, fq), qf[ks], acc[nt], 0, 0, 0); }
        float s = 0.f;
#pragma unroll
        for (int nt = 0; nt < 16; ++nt) s += (acc[nt][0] + acc[nt][1]) + (acc[nt][2] + acc[nt][3]);
        s += __shfl_xor(s, 16); s += __shfl_xor(s, 32);
        const float mu = s * (1.f / 256.f); float q = 0.f;
#pragma unroll
        for (int nt = 0; nt < 16; ++nt) { const f32x4 d = acc[nt] - mu; q += (d[0] * d[0] + d[1] * d[1]) + (d[2] * d[2] + d[3] * d[3]); }
        q += __shfl_xor(q, 16); q += __shfl_xor(q, 32);
        const float rstd = 1.0f / sqrtf(q * (1.f / 256.f) + NORM_EPS);
        LDS_BARRIER();
        LAS unsigned char* stg = sV + wid * (16 * 528); int tg2 = lane; asm volatile("" : "+v"(tg2));
#pragma unroll
        for (int i2 = 0; i2 < 8; ++i2) { const int id = tg2 + 64 * i2; *(LAS u32x4*)(stg + (id >> 5) * 528 + (id & 31) * 16) = gsr[i2]; }
        LDS_WAIT(); asm volatile("" ::: "memory");
#pragma unroll
        for (int nt = 0; nt < 16; ++nt) { const int col = nt * 16 + 4 * fq; const f32x4 gg = *(const f32x4*)(gng + h * 256 + col); LAS u32x2* sp = (LAS u32x2*)(stg + fr * 528 + col * 2); const u32x2 gs = *sp;
            const f32x4 y = (acc[nt] - mu) * rstd * gg;
            u32x2 o; o.x = pkbf(y[0] * bflo(gs.x), y[1] * bfhi(gs.x)); o.y = pkbf(y[2] * bflo(gs.y), y[3] * bfhi(gs.y));
            *sp = o; }
        LDS_WAIT(); asm volatile("" ::: "memory"); int tg3 = lane; asm volatile("" : "+v"(tg3));
#pragma unroll
        for (int i2 = 0; i2 < 8; ++i2) { const int id = tg3 + 64 * i2; *(u32x4*)(RETG + (size_t)(tok0 + wid * 16 + (id >> 5)) * 1024 + h * 256 + (id & 31) * 8) = *(const LAS u32x4*)(stg + (id >> 5) * 528 + (id & 31) * 16); }
        LDS_BARRIER();
        if (!has) break;
        it = nit;
#pragma unroll
        for (int ks = 0; ks < 4; ++ks) qf[ks] = qn[ks];
    }
#undef RC_LOAD
}

__device__ __forceinline__ void s5_scan(Frame& F, int first, int stride) {
    const int lane_o = otid() & 63;
    const float* VB = (const float*)(F.ws + WS_VBUF); bf16_t* AS5 = (bf16_t*)(F.ws + WS_AS5); const float* DB = (const float*)(F.ws + WS_DBUF);
    LAS float* TOT = (LAS float*)F.lds;
    for (int it = first; it < NB * S5G; it += stride) {
        const int b = it & 3, g = it >> 2, n = lane_o, seg = F.wave; const float dr = DB[(g * 64 + n) * 2], di = DB[(g * 64 + n) * 2 + 1];
        const size_t row0 = (size_t)g * 1024 + b * 256 + seg * 32;
        float vr[32], vi[32];
#pragma unroll
        for (int j = 0; j < 32; ++j) { vr[j] = VB[(row0 + j) * 128 + n]; vi[j] = VB[(row0 + j) * 128 + 64 + n]; }
        float lr[32], li[32]; float sr = 0.f, si = 0.f;
#pragma unroll
        for (int j = 0; j < 32; ++j) { lr[j] = sr; li[j] = si; const float tr = dr * sr - di * si + vr[j]; si = dr * si + di * sr + vi[j]; sr = tr; }
        TOT[(seg * 64 + n) * 2] = sr; TOT[(seg * 64 + n) * 2 + 1] = si;
        float p32r = 1.f, p32i = 0.f;
#pragma unroll
        for (int j = 0; j < 32; ++j) { const float tr = p32r * dr - p32i * di; p32i = p32r * di + p32i * dr; p32r = tr; }
        __syncthreads();
        float cr = 0.f, ci = 0.f;
        for (int s2 = 0; s2 < seg; ++s2) { const float tr_ = TOT[(s2 * 64 + n) * 2], ti_ = TOT[(s2 * 64 + n) * 2 + 1]; const float tr = p32r * cr - p32i * ci + tr_; ci = p32r * ci + p32i * cr + ti_; cr = tr; }
        float pr = 1.f, pi = 0.f;
#pragma unroll
        for (int j = 0; j < 32; ++j) {
            const float xr = lr[j] + pr * cr - pi * ci, xi = li[j] + pr * ci + pi * cr;
            bf16_t* ap = AS5 + (row0 + j) * 640 + 512 + n; ap[0] = (bf16_t)(pkbf(xr, 0.f) & 0xffff); ap[64] = (bf16_t)(pkbf(xi, 0.f) & 0xffff);
            const float tr = pr * dr - pi * di; pi = pr * di + pi * dr; pr = tr;
        }
        __syncthreads();
    }
}

#define TOP4_INS(val, idx) do { const float v_ = (val); const int i_ = (idx); const bool c0 = v_ > b0, c1 = v_ > b1, c2 = v_ > b2, c3 = v_ > b3; \
    b3 = c2 ? b2 : (c3 ? v_ : b3); i3 = c2 ? i2 : (c3 ? i_ : i3); b2 = c1 ? b1 : (c2 ? v_ : b2); i2 = c1 ? i1 : (c2 ? i_ : i2); \
    b1 = c0 ? b0 : (c1 ? v_ : b1); i1 = c0 ? i0 : (c1 ? i_ : i1); b0 = c0 ? v_ : b0; i0 = c0 ? i_ : i0; } while (0)
__device__ __forceinline__ void p8_router(Frame& F) {
    const int tid_o = otid(), lane_o = tid_o & 63;
    const int tid = tid_o, lane = lane_o, wid = F.wave, fr = lane & 15, fq = lane >> 4;
    LAS unsigned char* Wh = F.lds; LAS unsigned char* Wl = F.lds + 65536;
    LAS unsigned* lcnt = (LAS unsigned*)(F.lds + LDS_P8); LAS unsigned* lbase = lcnt + 32; LAS int* ent = (LAS int*)(F.lds + LDS_P8 + 256);
    const float* rw = inp(I_RW); const bf16_t* x1 = (const bf16_t*)(F.ws + WS_X1); unsigned char* H2 = (unsigned char*)(F.ws + WS_H2); const float* gg = inp(I_NFG); const float* rb = inp(I_RB);
    const float* rss = (const float*)(F.ws + WS_ROWSS);
    LAS float* gl = (LAS float*)ent;
    int* etok = (int*)(F.ws + WS_ETOK); int* inv = (int*)(F.ws + WS_INV); float* gate4 = (float*)(F.ws + WS_GATE4);
    for (int chn = blockIdx.x; chn < T / 128; chn += F.G) {
        const int tok = chn * 128 + wid * 16 + fr;
        const bf16_t* xrow = x1 + (size_t)tok * DM + fq * 8; unsigned char* hrow = H2 + (size_t)tok * DM + fq * 8; const LAS float* grow = gl + fq * 8;
        u32x4 xq[8];
#pragma unroll
        for (int i = 0; i < 8; ++i) xq[i] = __builtin_nontemporal_load((const u32x4*)(xrow + i * 32));
        { f32x4 wv[16];
#pragma unroll
          for (int it = 0; it < 16; ++it) wv[it] = *(const f32x4*)(rw + 4 * (tid + NTHREADS * it));
#pragma unroll
          for (int it = 0; it < 16; ++it) { const int i = 4 * (tid + NTHREADS * it), k = i >> 5, e0 = i & 31;
#pragma unroll
            for (int j = 0; j < 4; ++j) { const int e = e0 + j; const float w = wv[it][j];
                const unsigned hb = pkbf(w, 0.f) & 0xffffu; const float wl = w - __uint_as_float(hb << 16); const unsigned lb = pkbf(wl, 0.f) & 0xffffu;
                const int off = e * 2048 + ((((k >> 3) ^ (e & 15))) << 4) + (k & 7) * 2;
                *(LAS bf16_t*)(Wh + off) = (bf16_t)hb; *(LAS bf16_t*)(Wl + off) = (bf16_t)lb; } } }
        if (tid < 32) lcnt[tid] = 0u;
        if (tid < 256) *(LAS f32x4*)(gl + 4 * tid) = *(const f32x4*)(gg + 4 * tid);
        __syncthreads();
        float rs; { const f32x4* p = (const f32x4*)(rss + (size_t)tok * 16); const f32x4 a = p[0], b = p[1], c = p[2], d = p[3];
            const float ss = (((a[0] + a[1]) + (a[2] + a[3])) + ((b[0] + b[1]) + (b[2] + b[3]))) + (((c[0] + c[1]) + (c[2] + c[3])) + ((d[0] + d[1]) + (d[2] + d[3])));
            rs = 1.0f / sqrtf(ss * (1.f / DM) + NORM_EPS); }
        f32x4 acc[2]; acc[0] = (f32x4){0.f, 0.f, 0.f, 0.f}; acc[1] = acc[0];
#pragma nounroll
        for (int kb = 0; kb < 4; ++kb) {
        u32x4 xc[8];
#pragma unroll
        for (int i = 0; i < 8; ++i) xc[i] = xq[i];
        if (kb < 3) {
#pragma unroll
            for (int i = 0; i < 8; ++i) xq[i] = __builtin_nontemporal_load((const u32x4*)(xrow + (kb * 8 + 8 + i) * 32));
        }
#pragma unroll
        for (int ki = 0; ki < 8; ++ki) { const int ks = kb * 8 + ki;
            const u32x4 xp = xc[ki]; const f32x4 xa = (f32x4){bflo(xp.x), bfhi(xp.x), bflo(xp.y), bfhi(xp.y)}, xb = (f32x4){bflo(xp.z), bfhi(xp.z), bflo(xp.w), bfhi(xp.w)};
            const f32x4 ga = *(const LAS f32x4*)(grow + ks * 32), gb = *(const LAS f32x4*)(grow + ks * 32 + 4);
            const f32x4 ha = xa * rs * ga, hb = xb * rs * gb;
            u32x4 hp; hp.x = pkbf(ha[0], ha[1]); hp.y = pkbf(ha[2], ha[3]); hp.z = pkbf(hb[0], hb[1]); hp.w = pkbf(hb[2], hb[3]);
            { u32x2 h8; h8.x = pkfp8x4(ha[0], ha[1], ha[2], ha[3]); h8.y = pkfp8x4(hb[0], hb[1], hb[2], hb[3]); *(u32x2*)(hrow + ks * 32) = h8; }
            u32x4 lp; lp.x = pkbf(ha[0] - bflo(hp.x), ha[1] - bfhi(hp.x)); lp.y = pkbf(ha[2] - bflo(hp.y), ha[3] - bfhi(hp.y)); lp.z = pkbf(hb[0] - bflo(hp.z), hb[1] - bfhi(hp.z)); lp.w = pkbf(hb[2] - bflo(hp.w), hb[3] - bfhi(hp.w));
            const bf16x8 hv = __builtin_bit_cast(bf16x8, hp), lv = __builtin_bit_cast(bf16x8, lp);
#pragma unroll
            for (int et = 0; et < 2; ++et) { const int e = et * 16 + fr, off = e * 2048 + (((ks * 4 + fq) ^ (e & 15)) << 4);
                const bf16x8 wh = *(const LAS bf16x8*)(Wh + off), wl = *(const LAS bf16x8*)(Wl + off);
                acc[et] = __builtin_amdgcn_mfma_f32_16x16x32_bf16(wh, hv, acc[et], 0, 0, 0);
                acc[et] = __builtin_amdgcn_mfma_f32_16x16x32_bf16(wl, hv, acc[et], 0, 0, 0);
                acc[et] = __builtin_amdgcn_mfma_f32_16x16x32_bf16(wh, lv, acc[et], 0, 0, 0); }
        }
        }
        __syncthreads();
        LAS float* lgt = (LAS float*)F.lds + wid * 512;
#pragma unroll
        for (int et = 0; et < 2; ++et) { const f32x4 bb = *(const f32x4*)(rb + et * 16 + 4 * fq); *(LAS f32x4*)(lgt + fr * 32 + et * 16 + 4 * fq) = acc[et] + bb; }
        LDS_WAIT(); asm volatile("" ::: "memory");
        if (lane < 16) {
            float b0 = -__builtin_inff(), b1 = b0, b2 = b0, b3 = b0; int i0 = 0, i1 = 0, i2 = 0, i3 = 0;
#pragma unroll
            for (int q = 0; q < 8; ++q) { const f32x4 v4 = *(const LAS f32x4*)(lgt + lane * 32 + q * 4); TOP4_INS(v4[0], q * 4); TOP4_INS(v4[1], q * 4 + 1); TOP4_INS(v4[2], q * 4 + 2); TOP4_INS(v4[3], q * 4 + 3); }
            const float e1 = __expf(b1 - b0), e2 = __expf(b2 - b0), e3 = __expf(b3 - b0), inv = 1.0f / (1.0f + e1 + e2 + e3);
            const int t2 = chn * 128 + wid * 16 + lane; LAS int* en = ent + ((wid * 16 + lane) * 4) * 4;
            { const unsigned lp = atomicAdd((unsigned*)&lcnt[i0], 1u); en[0] = i0; en[1] = t2 * 4 + 0; en[2] = __float_as_int(inv); en[3] = (int)lp; }
            { const unsigned lp = atomicAdd((unsigned*)&lcnt[i1], 1u); en[4] = i1; en[5] = t2 * 4 + 1; en[6] = __float_as_int(e1 * inv); en[7] = (int)lp; }
            { const unsigned lp = atomicAdd((unsigned*)&lcnt[i2], 1u); en[8] = i2; en[9] = t2 * 4 + 2; en[10] = __float_as_int(e2 * inv); en[11] = (int)lp; }
            { const unsigned lp = atomicAdd((unsigned*)&lcnt[i3], 1u); en[12] = i3; en[13] = t2 * 4 + 3; en[14] = __float_as_int(e3 * inv); en[15] = (int)lp; }
        }
        __syncthreads();
        if (tid < 32) { lbase[tid] = atomicAdd(F.ctl + CW_ECNT + 64 * tid, lcnt[tid]); }
        __syncthreads();
        { const LAS int* en = ent + tid * 4; const int e = en[0]; const unsigned pos = lbase[e] + (unsigned)en[3];
          etok[(size_t)e * T + pos] = en[1]; inv[en[1]] = e * 32768 + (int)pos; gate4[en[1]] = __int_as_float(en[2]); }
        __syncthreads();
    }
}

__device__ __forceinline__ int build_tiles(Frame& F) {
    const int tid_o = otid();
    LAS int* pst = (LAS int*)(F.lds + LDS_PST); LAS int* cl = (LAS int*)(F.lds + LDS_CNT); LAS unsigned char* tile_e = F.lds + LDS_TILEE;
    __syncthreads();
    if (tid_o < 32) cl[tid_o] = (int)__hip_atomic_load(F.ctl + CW_ECNT + 64 * tid_o, __ATOMIC_RELAXED, __HIP_MEMORY_SCOPE_AGENT);
    __syncthreads();
    if (tid_o == 0) { int a = 0; for (int e = 0; e < 32; ++e) { pst[e] = a; a += (cl[e] + 255) & ~255; } pst[32] = a; }
    __syncthreads();
    const int ntiles = pst[32] >> 8;
    for (int t = tid_o; t < ntiles; t += NTHREADS) { int lo = 0;
        for (int st = 16; st >= 1; st >>= 1) if (t * 256 >= pst[lo + st]) lo += st;
        tile_e[t] = (unsigned char)lo; }
    __syncthreads();
    return ntiles;
}

__device__ __forceinline__ void p12_final(Frame& F, bool have_tables) {
    if (!have_tables) build_tiles(F);
    const int lane_o = otid() & 63; const LAS int* pst = (const LAS int*)(F.lds + LDS_PST);
    const int gw = F.vcu * NWAVES + F.wave, NGW = F.G * NWAVES; const unsigned char* YK = (const unsigned char*)(F.ws + WS_YK); const float* gg = inp(I_NFIN);
    const u32x4* inv = (const u32x4*)(F.ws + WS_INV); const f32x4* gate4 = (const f32x4*)(F.ws + WS_GATE4);
    f32x4 gv[4];
#pragma unroll
    for (int j = 0; j < 4; ++j) gv[j] = *((const f32x4*)gg + lane_o + 64 * j);
    u32x4 iv = inv[gw < T ? gw : 0]; f32x4 gt = gate4[gw < T ? gw : 0];
    for (int tok = gw; tok < T; tok += NGW) {
        const int r0 = pst[iv.x >> 15] + (int)(iv.x & 32767u), r1 = pst[iv.y >> 15] + (int)(iv.y & 32767u), r2 = pst[iv.z >> 15] + (int)(iv.z & 32767u), r3 = pst[iv.w >> 15] + (int)(iv.w & 32767u);
        const int* yr[4] = { (const int*)(YK + (size_t)r0 * DM) + lane_o, (const int*)(YK + (size_t)r1 * DM) + lane_o, (const int*)(YK + (size_t)r2 * DM) + lane_o, (const int*)(YK + (size_t)r3 * DM) + lane_o };
        const float gk[4] = { gt[0], gt[1], gt[2], gt[3] };
        const int nx = tok + NGW < T ? tok + NGW : tok; iv = inv[nx]; gt = gate4[nx];
        f32x4* xr = (f32x4*)(F.out + (size_t)tok * DM) + lane_o; const u32x2* x1r = (const u32x2*)((const bf16_t*)(F.ws + WS_X1) + (size_t)tok * DM) + lane_o; f32x4 v[4]; float s = 0.f;
#pragma unroll
        for (int j = 0; j < 4; ++j) { const u32x2 xp = __builtin_nontemporal_load(x1r + 64 * j); v[j] = (f32x4){bflo(xp.x), bfhi(xp.x), bflo(xp.y), bfhi(xp.y)};
#pragma unroll
            for (int k = 0; k < 4; ++k) { const int y = __builtin_nontemporal_load(yr[k] + 64 * j); const f32x2 lo = __builtin_amdgcn_cvt_pk_f32_fp8(y, false), hi = __builtin_amdgcn_cvt_pk_f32_fp8(y, true);
                v[j].x += gk[k] * lo[0]; v[j].y += gk[k] * lo[1]; v[j].z += gk[k] * hi[0]; v[j].w += gk[k] * hi[1]; }
            s += (v[j].x * v[j].x + v[j].y * v[j].y) + (v[j].z * v[j].z + v[j].w * v[j].w); }
        const float rs = 1.0f / sqrtf(wave_sum(s) * (1.f / DM) + NORM_EPS);
#pragma unroll
        for (int j = 0; j < 4; ++j) __builtin_nontemporal_store(v[j] * rs * gv[j], xr + 64 * j);
    }
}

constexpr int N_PHASES = 12;
struct Args { const float* in[26]; float* out; unsigned char* ws; int ph_lo, ph_hi, li, pad; };
__global__ void __launch_bounds__(NTHREADS, 2) fwd_kernel(Args args) {
    extern __shared__ __attribute__((aligned(16))) unsigned char lds[];
    Frame F;
    F.lds = (LAS unsigned char*)lds;
    const int tid_o = threadIdx.x; F.wave = __builtin_amdgcn_readfirstlane(tid_o >> 6);
    F.G = gridDim.x; { const int bx = blockIdx.x; F.vcu = (F.G % 8 == 0) ? (bx % 8) * (F.G / 8) + bx / 8 : bx; }
    F.ws = args.ws; F.ctl = (unsigned*)(args.ws + WS_CTL); F.out = args.out;
    for (int u = tid_o; u < (LDS_BYTES - LDSCTL_OFF) / 4; u += NTHREADS) ((LAS unsigned*)(F.lds + LDSCTL_OFF))[u] = 0u;
    __syncthreads();
    XcdBarrier bar; bar.bar = F.ctl + CW_BAR + args.li * XCD_BAR_WORDS; bar.x = 0; bar.st = nullptr;
    if (args.ph_hi - args.ph_lo > 1) bar = xcd_barrier_post(F.ctl + CW_BAR + args.li * XCD_BAR_WORDS, (volatile LAS unsigned*)(F.lds + LDSCTL_OFF) + 8);
    const int lo = args.ph_lo, hi = args.ph_hi;
#ifndef PHMASK
#define PHMASK 0xfff
#endif
#define IN(k) (((PHMASK >> (k)) & 1) && lo <= (k) && (k) < hi)
#define SEAM(k) do { if (IN(k) && IN((k) + 1)) xcd_barrier(bar); } while (0)
    LAS unsigned char* tile_e = F.lds + LDS_TILEE;

    if (IN(0)) { p0_prologue(F); SEAM(0); }
    if (IN(1)) {
        { pg8::Gemm g{(const void*)(F.ws + WS_H), (const void*)(F.ws + WS_WIN), 2048, 2048, 2048}; pg8::StaticOrder S; S.init(T / 256, IN_BF_TILES, F.G, (int)blockIdx.x);
          EpiInProj<false> E{F.ws};
          pg8::gemm_phase<EpiInProj<false>, pg8::StaticOrder, true>(F.lds, g, S, E); }
        { pg8::Gemm g{(const void*)(F.ws + WS_H8), (const void*)(F.ws + WS_WIN8), 1024, 1024, 1024}; pg8::StaticOrder S; S.init(T / 256, 22 - IN_BF_TILES, F.G, (int)blockIdx.x);
          EpiInProj<true> E{F.ws};
          pg8::gemm_phase<EpiInProj<true>, pg8::StaticOrder, true>(F.lds, g, S, E); }
        SEAM(1);
    }
    if (IN(2)) {
        ret_pass_a(F);
        pg8::Gemm g{(const bf16_t*)(F.ws + WS_AS5), (const bf16_t*)(F.ws + WS_BTV), S5K * 2, 1024, 1024}; pg8::GroupOrder S; S.init(S5G, 4, 1, 1024, 256, F.G, (int)blockIdx.x);
        EpiS5V E{(float*)(F.ws + WS_VBUF)};
        pg8::gemm_phase<EpiS5V, pg8::GroupOrder, true>(F.lds, g, S, E);
        SEAM(2);
    }
    if (IN(3)) { ret_pass_b(F); s5_scan(F, F.vcu, F.G); SEAM(3); }
    if (IN(4)) {
        ret_pass_c(F);
        pg8::Gemm g{(const bf16_t*)(F.ws + WS_AS5), (const bf16_t*)(F.ws + WS_BTY), S5K * 2, S5K * 2, S5K * 2}; pg8::GroupOrder S; S.init(S5G, 4, 2, 1024, 512, F.G, (int)blockIdx.x);
        EpiS5Y E{(const bf16_t*)(F.ws + WS_AS5), (bf16_t*)(F.ws + WS_Z), inp(I_D)};
        pg8::gemm_phase<EpiS5Y, pg8::GroupOrder, true>(F.lds, g, S, E);
        SEAM(4);
    }
    if (IN(5)) {
        pg8::Gemm g{(const bf16_t*)(F.ws + WS_Z), (const bf16_t*)(F.ws + WS_WGLU), 1024, 1024, 1024}; pg8::StaticOrder S; S.init(T / 256, 2, F.G, (int)blockIdx.x);
        EpiGlu E{(const bf16_t*)(F.ws + WS_Z), (bf16_t*)(F.ws + WS_YS5), inp(I_BGLU)};
        pg8::gemm_phase<EpiGlu, pg8::StaticOrder, true>(F.lds, g, S, E);
        SEAM(5);
    }
    if (IN(6)) {
        pg8::ChainOrder S; S.so.init(T / 256, 4, F.G, (int)blockIdx.x);
        pg8::Gemm g{(const bf16_t*)(F.ws + WS_YS5), (const bf16_t*)(F.ws + WS_WCAT), 1024, 3072, 1024, (const bf16_t*)(F.ws + WS_RETG), 2048, 2048};
        EpiChain E{(const bf16_t*)(F.ws + WS_SA), (const bf16_t*)(F.ws + WS_SB), (bf16_t*)(F.ws + WS_MERGED)};
        pg8::gemm_phase<EpiChain, pg8::ChainOrder, true>(F.lds, g, S, E);
        SEAM(6);
    }
    if (IN(7)) {
        pg8::Gemm g{(const bf16_t*)(F.ws + WS_MERGED), (const bf16_t*)(F.ws + WS_WOUT), 2048, 2048, 2048}; pg8::StaticOrder S; S.init(T / 256, 4, F.G, (int)blockIdx.x);
        EpiResid E{inp(I_X), (bf16_t*)(F.ws + WS_X1), (float*)(F.ws + WS_ROWSS)};
        pg8::gemm_phase<EpiResid, pg8::StaticOrder, true>(F.lds, g, S, E);
        SEAM(7);
    }
    if (IN(8)) { p8_router(F); SEAM(8); }
    if (IN(9)) {
        const int ntiles = build_tiles(F);
        pg8::Gemm g{(const void*)(F.ws + WS_H2), (const void*)(F.ws + WS_W1), 1024, 1024, 1024};
        pg8::ExpertOrder<true> S; S.so.init(ntiles, 8, F.G, (int)blockIdx.x); S.tile_e = tile_e; S.nfull = 2048; S.pst = (const LAS int*)(F.lds + LDS_PST); S.cl = (const LAS int*)(F.lds + LDS_CNT); S.etok = (const int*)(F.ws + WS_ETOK); S.egate = nullptr;
        EpiSwiglu E{inp(I_B1), (unsigned char*)(F.ws + WS_ACT)};
        pg8::gemm_phase<EpiSwiglu, pg8::ExpertOrder<true>, true>(F.lds, g, S, E);
        SEAM(9);
    }
    if (IN(10)) {
        const int ntiles = IN(9) ? (((const LAS int*)(F.lds + LDS_PST))[32] >> 8) : build_tiles(F);
        pg8::Gemm g{(const void*)(F.ws + WS_ACT), (const void*)(F.ws + WS_W2), 1024, 1024, 1024};
        pg8::ExpertOrder<false> S; S.so.init(ntiles, 4, F.G, (int)blockIdx.x); S.tile_e = tile_e; S.nfull = 1024; S.pst = (const LAS int*)(F.lds + LDS_PST); S.cl = (const LAS int*)(F.lds + LDS_CNT); S.etok = (const int*)(F.ws + WS_ETOK); S.egate = nullptr;
#if defined(PROBE_FASTA)
        if (args.li == 1) S.amask = 0;
#endif
        EpiExpOut E{inp(I_B2), (unsigned char*)(F.ws + WS_YK)};
        pg8::gemm_phase<EpiExpOut, pg8::ExpertOrder<false>, true>(F.lds, g, S, E);
        SEAM(10);
    }
    if (IN(11)) { p12_final(F, IN(9)); }
#undef IN
#undef SEAM
}

extern "C" void kernel_launch(void* const* d_in, const int* in_sizes, int n_in, void* d_out, int out_size, void* d_ws, size_t ws_size, hipStream_t stream) {
    static int grid = 0;
    if (grid == 0) {
        if (n_in != 26 || in_sizes[0] != T * DM || out_size != T * DM || ws_size < WS_END) { fprintf(stderr, "kernel_launch: unexpected shapes (n_in %d, in0 %d, out %d, ws %zu); nothing launched\n", n_in, n_in > 0 ? in_sizes[0] : -1, out_size, ws_size); grid = -1; return; }
        int dev = 0, cus = 0, per_cu = 0;
        if (hipGetDevice(&dev) != hipSuccess || hipDeviceGetAttribute(&cus, hipDeviceAttributeMultiprocessorCount, dev) != hipSuccess) { grid = -1; return; }
        if (hipFuncSetAttribute((const void*)fwd_kernel, hipFuncAttributeMaxDynamicSharedMemorySize, LDS_BYTES) != hipSuccess) { fprintf(stderr, "kernel_launch: hipFuncSetAttribute failed\n"); grid = -1; return; }
        if (hipOccupancyMaxActiveBlocksPerMultiprocessor(&per_cu, (const void*)fwd_kernel, NTHREADS, LDS_BYTES) != hipSuccess || per_cu < 1) { fprintf(stderr, "kernel_launch: the occupancy query admits %d workgroups of this kernel per CU; nothing launched\n", per_cu); grid = -1; return; }
        (void)hipGetLastError();
        grid = cus;
    }
    if (grid < 0) return;
    (void)hipMemsetAsync((char*)d_ws + WS_CTL, 0, CTL_ZERO_BYTES, stream);
    Args a{};
    for (int i = 0; i < 26; ++i) a.in[i] = (const float*)d_in[i];
    a.out = (float*)d_out; a.ws = (unsigned char*)d_ws;
#if defined(PROBE_FASTA)
    a.ph_lo = 0; a.ph_hi = 10; a.li = 0; hipLaunchKernelGGL(fwd_kernel, dim3(grid), dim3(NTHREADS), LDS_BYTES, stream, a);
    a.ph_lo = 10; a.ph_hi = 11; a.li = 1; hipLaunchKernelGGL(fwd_kernel, dim3(grid), dim3(NTHREADS), LDS_BYTES, stream, a);
    a.ph_lo = 10; a.ph_hi = N_PHASES; a.li = 2; hipLaunchKernelGGL(fwd_kernel, dim3(grid), dim3(NTHREADS), LDS_BYTES, stream, a);
#elif defined(PROBE_PHASE)
    { const int k = PROBE_PHASE;
      a.ph_lo = 0; a.ph_hi = k + 1; a.li = 0; hipLaunchKernelGGL(fwd_kernel, dim3(grid), dim3(NTHREADS), LDS_BYTES, stream, a);
      if (k == 8) (void)hipMemsetAsync((char*)d_ws + WS_CTL + CW_ECNT * 4, 0, 32 * 256, stream);
      a.ph_lo = k; a.ph_hi = k + 1; a.li = 1; hipLaunchKernelGGL(fwd_kernel, dim3(grid), dim3(NTHREADS), LDS_BYTES, stream, a);
      if (k + 1 < N_PHASES) { a.ph_lo = k + 1; a.ph_hi = N_PHASES; a.li = 2; hipLaunchKernelGGL(fwd_kernel, dim3(grid), dim3(NTHREADS), LDS_BYTES, stream, a); } }
#else
    if (MK_N_LAUNCHES == 1) {
        a.ph_lo = 0; a.ph_hi = N_PHASES; a.li = 0;
        hipLaunchKernelGGL(fwd_kernel, dim3(grid), dim3(NTHREADS), LDS_BYTES, stream, a);
    } else {
        for (int p = 0; p < N_PHASES; ++p) { a.ph_lo = p; a.ph_hi = p + 1; a.li = 0; hipLaunchKernelGGL(fwd_kernel, dim3(grid), dim3(NTHREADS), LDS_BYTES, stream, a); }
    }
#endif
}
```

```cpp
#include <hip/hip_runtime.h>
#include <cstdio>
#include <cstdint>

#define LAS __attribute__((address_space(3)))
#define GAS __attribute__((address_space(1)))
typedef unsigned short bf16_t;
typedef short bf16x8 __attribute__((ext_vector_type(8)));
typedef float f32x4 __attribute__((ext_vector_type(4)));
typedef float f32x2 __attribute__((ext_vector_type(2)));
typedef unsigned u32x4 __attribute__((ext_vector_type(4)));
typedef unsigned u32x2 __attribute__((ext_vector_type(2)));
typedef int i32x4 __attribute__((ext_vector_type(4)));
typedef int i32x8 __attribute__((ext_vector_type(8)));

#ifndef MK_N_LAUNCHES
#define MK_N_LAUNCHES 1
#endif

constexpr int NB = 4, SEQ = 8192, T = NB * SEQ, DM = 1024, INW = 5632;
constexpr int S5W = 512, S5G = 32, S5N = 64, S5Q = 32, S5NCH = SEQ / S5Q, S5ROWS = NB * S5NCH, S5K = 640;
constexpr int RH = 4, RDK = 128, RDV = 256, RC = 128, RNC = SEQ / RC;
constexpr int NE = 32, DFF = 1024, MAXTILES = 544, MAXROWS = MAXTILES * 256;
constexpr float NORM_EPS = 1e-5f;

__device__ __forceinline__ unsigned pkbf(float lo, float hi) { typedef __bf16 bf2 __attribute__((ext_vector_type(2))); f32x2 v = {lo, hi}; bf2 b = __builtin_convertvector(v, bf2); return __builtin_bit_cast(unsigned, b); }
__device__ __forceinline__ unsigned pkfp8x4(float a, float b, float c, float d) { int p = 0; p = __builtin_amdgcn_cvt_pk_fp8_f32(a, b, p, false); p = __builtin_amdgcn_cvt_pk_fp8_f32(c, d, p, true); return (unsigned)p; }
__device__ __forceinline__ float bflo(unsigned u) { return __uint_as_float(u << 16); }
__device__ __forceinline__ float bfhi(unsigned u) { return __uint_as_float(u & 0xffff0000u); }
__device__ __forceinline__ float fsigmoid(float x) { return __builtin_amdgcn_rcpf(1.0f + __builtin_amdgcn_exp2f(-1.4426950408889634f * x)); }
typedef float f32x2 __attribute__((ext_vector_type(2)));
__device__ __forceinline__ f32x2 fsigmoid2(f32x2 x) { const f32x2 t = x * -1.4426950408889634f; const f32x2 d = f32x2{__builtin_amdgcn_exp2f(t.x), __builtin_amdgcn_exp2f(t.y)} + 1.0f; return f32x2{__builtin_amdgcn_rcpf(d.x), __builtin_amdgcn_rcpf(d.y)}; }
__device__ __forceinline__ float wave_sum(float v) {
#pragma unroll
    for (int o = 1; o < 64; o <<= 1) v += __shfl_xor(v, o);
    return v;
}
#define LDS_WAIT() asm volatile("s_waitcnt lgkmcnt(0)" ::: "memory")
#define VM_WAIT() asm volatile("s_waitcnt vmcnt(0)" ::: "memory")
#define LDS_BARRIER() do { asm volatile("s_waitcnt lgkmcnt(0)" ::: "memory"); __builtin_amdgcn_s_barrier(); asm volatile("" ::: "memory"); } while (0)

namespace pg8 {
constexpr int BM = 256, BK = 64, HALF = 128, HTB = HALF * BK * 2, STAGE_BYTES = 8 * HTB, NXCD = 8, WGM = 8;
constexpr int TOKBUF_OFF = 131072 + 13312;
constexpr int ROWBUF_OFF = 131072 + 1024;
__host__ __device__ __forceinline__ int lds_byte(int r, int c) { const int st = (r >> 4) * 2 + (c >> 5), rr = r & 15, cc = c & 31, ob = rr * 64 + cc * 2; return st * 1024 + (ob ^ (((ob >> 9) & 1) << 5)); }
__host__ __device__ __forceinline__ void stage_rc(int b, int& R, int& C) { const int st = b / 1024, sb = b % 1024, swz = sb ^ (((sb >> 9) & 1) << 5); R = (st >> 1) * 16 + swz / 64; C = (st & 1) * 32 + (swz % 64) / 2; }
__host__ __device__ __forceinline__ int perm32(int rho) { const int n = rho >> 4, i = rho & 15; return 8 * (i >> 2) + 4 * n + (i & 3); }

struct Unit { int pm, pn, arow, brow, aux, slot, seg; };
struct Gemm { const void* A; const void* Bt; int lda, ldb, K; const void* A2 = nullptr; int lda2 = 0, K2 = 0; };

struct StaticOrder {
    static constexpr bool GATHER = false, ROWINFO = false, CHAIN = false;
    int nM, nN, nwg, G, c;
    __device__ void init(int nM_, int nN_, int G_, int c_) { nM = nM_; nN = nN_; nwg = nM * nN; G = G_; c = c_; }
    __device__ __forceinline__ bool tile(int i, int& pm, int& pn) const {
        const long L = (long)i * G + c; if (L >= nwg) return false;
        int wgid = (int)L; { const int q = nwg / NXCD, r = nwg % NXCD, xcd = wgid % NXCD, off = wgid / NXCD; wgid = (xcd < r ? xcd * (q + 1) : r * (q + 1) + (xcd - r) * q) + off; }
        const int nig = WGM * nN, gid = wgid / nig, fm = gid * WGM, gsz = (nM - fm) < WGM ? (nM - fm) : WGM;
        pm = fm + ((wgid % nig) % gsz); pn = (wgid % nig) / gsz; return true;
    }
    __device__ __forceinline__ bool next(int i, Unit& u) const { if (!tile(i, u.pm, u.pn)) return false; u.arow = u.pm * BM; u.brow = u.pn * BM; u.aux = 0; return true; }
};
struct GroupOrder {
    static constexpr bool GATHER = false, ROWINFO = false, CHAIN = false;
    int nMg, nNg, per, nwg, G, c, arows, brows;
    __device__ void init(int ng, int nMg_, int nNg_, int arows_, int brows_, int G_, int c_) { nMg = nMg_; nNg = nNg_; per = nMg * nNg; nwg = ng * per; G = G_; c = c_; arows = arows_; brows = brows_; }
    __device__ __forceinline__ bool next(int i, Unit& u) const {
        const long L = (long)i * G + c; if (L >= nwg) return false;
        const int g = (int)L / per, r = (int)L % per; u.pm = r % nMg; u.pn = r / nMg; u.arow = g * arows + u.pm * BM; u.brow = g * brows + u.pn * BM; u.aux = g; return true;
    }
};
struct ChainOrder {
    static constexpr bool GATHER = false, ROWINFO = false, CHAIN = true;
    StaticOrder so;
    __device__ __forceinline__ bool next(int i, Unit& u) const { if (!so.tile(i >> 1, u.pm, u.pn)) return false; u.arow = u.pm * BM; u.brow = u.pn * BM; u.aux = 0; u.seg = i & 1; return true; }
};
template <bool GATHER_> struct ExpertOrder {
    static constexpr bool GATHER = GATHER_, ROWINFO = false, CHAIN = false;
    const float* egate; int amask = -1;
    StaticOrder so; const LAS unsigned char* tile_e; int nfull; const LAS int* pst; const LAS int* cl; const int* etok;
    __device__ __forceinline__ bool next(int i, Unit& u) const {
        if (!so.tile(i, u.pm, u.pn)) return false;
        const int e = (int)tile_e[u.pm]; u.arow = GATHER_ ? 0 : (u.pm * BM) & amask; u.brow = e * nfull + u.pn * BM; u.aux = e; return true;
    }
    __device__ __forceinline__ const int* tok_src(const Unit& u, int rho) const { const int e = u.aux, i = u.pm * BM + rho - pst[e]; return etok + (size_t)e * 32768 + (i < cl[e] ? i : 0); }
    __device__ __forceinline__ const float* gate_src(const Unit& u, int rho) const { const int e = u.aux, i = u.pm * BM + rho - pst[e]; return egate + (size_t)e * 32768 + (i < cl[e] ? i : 0); }
};

template <class Epi, class Sched, bool ALIGN_EPI>
__device__ __forceinline__ void gemm_phase(LAS unsigned char* lds, const Gemm g, const Sched& S, const Epi& E) {
    int tid_ = threadIdx.x; asm volatile("" : "+v"(tid_));
    const int tid = tid_, wid = __builtin_amdgcn_readfirstlane(tid >> 6), lane = tid & 63, wr = wid >> 2, wc = wid & 3, fr = lane & 15, fq = lane >> 4;
    const int nt0 = g.K / (BK * 2);
    unsigned voffA[2], voffB[2]; int stR[2], stC[2];
#pragma unroll
    for (int i = 0; i < 2; ++i) { int R, C; stage_rc(tid * 16 + i * 8192, R, C); const int Rb = Epi::PERM ? ((R & ~31) + perm32(R & 31)) : R; stR[i] = R; stC[i] = C;
        voffA[i] = (unsigned)(R * g.lda + C * 2); voffB[i] = (unsigned)(Rb * g.ldb + C * 2); }
    unsigned gv[2][2];
#pragma unroll
    for (int h = 0; h < 2; ++h)
#pragma unroll
        for (int i = 0; i < 2; ++i) gv[h][i] = voffA[i] + (unsigned)(h * HALF * g.lda);
    LAS int* tokbuf = (LAS int*)(lds + TOKBUF_OFF);
    const size_t kstep = (size_t)(BK * 2);
    const size_t hstepB = (size_t)HALF * g.ldb;
    const unsigned ldsw = (unsigned)wid * 1024u;
    const unsigned ldsbase = (unsigned)(size_t)lds + ldsw;
    const int aoff = lds_byte(wr * 64 + fr, fq * 8), boff = lds_byte(wc * 32 + fr, fq * 8);
#define PG8_SA(b, h) (((b) * 2 + (h)) * HTB)
#define PG8_SB(b, h) ((4 + (b) * 2 + (h)) * HTB)
#define PG8_STAGE(bufoff, gbase, voff) do { _Pragma("unroll") for (int _i = 0; _i < 2; ++_i) \
        asm volatile("s_mov_b32 m0, %2\n\ts_nop 0\n\tglobal_load_lds_dwordx4 %0, %1" :: "v"((voff)[_i]), "s"((const char*)(gbase)), "s"(ldsbase + (unsigned)((bufoff) + _i * 8192)) : "memory", "m0"); } while (0)
#define PG8_STAGE_A(bufoff, kptr, h) PG8_STAGE(bufoff, kptr, gv[h])
#define PG8_LD8(p) __builtin_shufflevector(*(const LAS i32x4*)(p), *(const LAS i32x4*)((p) + 1024), 0, 1, 2, 3, 4, 5, 6, 7)
#define PG8_LDA(dst, b, h) do { _Pragma("unroll") for (int m = 0; m < 4; ++m) dst[m] = PG8_LD8(lds + PG8_SA(b, h) + aoff + m * 2048); } while (0)
#define PG8_LDB(dst, b, h) do { _Pragma("unroll") for (int n = 0; n < 2; ++n) dst[n] = PG8_LD8(lds + PG8_SB(b, h) + boff + n * 2048); } while (0)
#define PG8_HALF(x, k) __builtin_bit_cast(bf16x8, __builtin_shufflevector(x, x, 4 * (k), 4 * (k) + 1, 4 * (k) + 2, 4 * (k) + 3))
#define PG8_MMA(ai, bj, At, Bt) do { __builtin_amdgcn_s_setprio(1); _Pragma("unroll") for (int m = 0; m < 4; ++m) _Pragma("unroll") for (int n = 0; n < 2; ++n) { \
        if constexpr (Epi::FP8) {   \
            acc[ai][bj][m][n] = __builtin_amdgcn_mfma_scale_f32_16x16x128_f8f6f4(Bt[n], At[m], acc[ai][bj][m][n], 0, 0, 0, 0x7a7a7a7a, 0, 0x7f7f7f7f); \
        } else { acc[ai][bj][m][n] = __builtin_amdgcn_mfma_f32_16x16x32_bf16(PG8_HALF(Bt[n], 0), PG8_HALF(At[m], 0), acc[ai][bj][m][n], 0, 0, 0); \
                 acc[ai][bj][m][n] = __builtin_amdgcn_mfma_f32_16x16x32_bf16(PG8_HALF(Bt[n], 1), PG8_HALF(At[m], 1), acc[ai][bj][m][n], 0, 0, 0); } } \
        __builtin_amdgcn_s_setprio(0); } while (0)
#define PG8_WAIT_V(n) asm volatile("s_waitcnt vmcnt(" #n ")" ::: "memory")
#define PG8_WAIT_L(n) asm volatile("s_waitcnt lgkmcnt(" #n ")" ::: "memory")
#define PG8_BAR __builtin_amdgcn_s_barrier()
#define PG8_SCHED __builtin_amdgcn_sched_barrier(0)
    Unit cur, nxt; int ui = 0;
    if (!S.next(0, cur)) return;
    typename Epi::Pre pre = E.prefetch(cur, wr, wc, fr, fq);
    f32x4 acc[2][2][4][2];
#pragma unroll
    for (int a = 0; a < 2; ++a)
#pragma unroll
        for (int b = 0; b < 2; ++b)
#pragma unroll
            for (int m = 0; m < 4; ++m)
#pragma unroll
                for (int n = 0; n < 2; ++n) { typedef unsigned long long u64x2 __attribute__((ext_vector_type(2))); u64x2 z;
                    asm volatile("v_mov_b64 %0, 0" : "=v"(z.x)); asm volatile("v_mov_b64 %0, 0" : "=v"(z.y)); acc[a][b][m][n] = __builtin_bit_cast(f32x4, z); }
    i32x8 At[4], B0[2], B1[2];
    const char* cA = (const char*)g.A + (size_t)cur.arow * g.lda; const char* cB = (const char*)g.Bt + (size_t)cur.brow * g.ldb;
    if constexpr (Sched::GATHER) {
#pragma unroll
        for (int h = 0; h < 2; ++h)
#pragma unroll
            for (int i = 0; i < 2; ++i) { const int tokk = *S.tok_src(cur, HALF * h + stR[i]); gv[h][i] = (unsigned)(tokk >> 2) * (unsigned)g.lda + (unsigned)stC[i] * 2u; }
    }
    if constexpr (Sched::ROWINFO) {
        LAS int* rb = (LAS int*)(lds + ROWBUF_OFF); if (tid < 256) rb[tid] = *S.tok_src(cur, tid); else rb[tid] = __float_as_int(*S.gate_src(cur, tid - 256));
    }
    PG8_STAGE(PG8_SB(0, 0), cB, voffB); PG8_STAGE(PG8_SB(0, 1), cB + hstepB, voffB); PG8_STAGE_A(PG8_SA(0, 0), cA, 0); PG8_STAGE_A(PG8_SA(0, 1), cA, 1);
    if (wr == 1) PG8_BAR;
    PG8_WAIT_V(2); PG8_BAR;
    PG8_STAGE(PG8_SB(1, 0), cB + kstep, voffB); PG8_STAGE_A(PG8_SA(1, 0), cA + kstep, 0); PG8_STAGE(PG8_SB(1, 1), cB + hstepB + kstep, voffB);
    PG8_WAIT_V(6); PG8_BAR;
    for (;;) {
        const bool has_next = S.next(ui + 1, nxt);
        const char* nA = has_next ? (const char*)g.A + (size_t)nxt.arow * g.lda : cA; const char* nB = has_next ? (const char*)g.Bt + (size_t)nxt.brow * g.ldb : cB;
        int nt = nt0;
        if constexpr (Sched::CHAIN) { if (has_next && nxt.seg) { nA = (const char*)g.A2 + (size_t)nxt.arow * g.lda2; nB += g.K; } if (cur.seg) nt = g.K2 / (BK * 2); }
        if constexpr (Sched::GATHER) {
            if (has_next && wid < 4) __builtin_amdgcn_global_load_lds((const unsigned*)S.tok_src(nxt, 64 * wid + lane), (LAS unsigned*)(tokbuf + ((ui + 1) & 1) * 256 + 64 * wid), 4, 0, 0);
        }
        if constexpr (Sched::ROWINFO) {
            if (has_next) { LAS unsigned* dst = (LAS unsigned*)(lds + ROWBUF_OFF) + ((ui + 1) % 3) * 512 + 64 * wid;
                const unsigned* src = wid < 4 ? (const unsigned*)S.tok_src(nxt, 64 * wid + lane) : (const unsigned*)S.gate_src(nxt, 64 * (wid - 4) + lane);
                __builtin_amdgcn_global_load_lds(src, dst, 4, 0, 0); }
        }
#pragma nounroll
        for (int t = 0; t < nt; t += 2) {
            const bool last = (t == nt - 2);
            const char* a1 = cA + (size_t)(t + 1) * kstep;
            const char* a2 = last ? nA : cA + (size_t)(t + 2) * kstep; const char* b2 = last ? nB : cB + (size_t)(t + 2) * kstep;
            const char* a3 = a2 + kstep; const char* b3 = b2 + kstep;
            PG8_LDB(B0, 0, 0); PG8_LDB(B1, 0, 1); PG8_SCHED; PG8_LDA(At, 0, 0); PG8_STAGE_A(PG8_SA(1, 1), a1, 1);
            if constexpr (!Sched::GATHER && !Sched::CHAIN) { if (last && has_next) { asm volatile("" : "+v"(gv[0][0]), "+v"(gv[0][1]), "+v"(gv[1][0]), "+v"(gv[1][1])); } }
            if constexpr (Sched::CHAIN) {
                if (last && has_next) { const int ldn = nxt.seg ? g.lda2 : g.lda;
#pragma unroll
                    for (int h = 0; h < 2; ++h)
#pragma unroll
                        for (int i = 0; i < 2; ++i) gv[h][i] = (unsigned)((HALF * h + stR[i]) * ldn + stC[i] * 2); }
            }
            if constexpr (Sched::GATHER) {
                if (last && has_next) {
#pragma unroll
                    for (int h = 0; h < 2; ++h)
#pragma unroll
                        for (int i = 0; i < 2; ++i) { const int tokk = tokbuf[((ui + 1) & 1) * 256 + HALF * h + stR[i]]; gv[h][i] = (unsigned)(tokk >> 2) * (unsigned)g.lda + (unsigned)stC[i] * 2u; }
                }
            }
            PG8_WAIT_V(8); PG8_WAIT_L(0); PG8_BAR; PG8_MMA(0, 0, At, B0); PG8_MMA(0, 1, At, B1); PG8_BAR; PG8_SCHED;
            PG8_STAGE(PG8_SB(0, 0), b2, voffB); PG8_STAGE(PG8_SB(0, 1), b2 + hstepB, voffB); PG8_STAGE_A(PG8_SA(0, 0), a2, 0); PG8_LDA(At, 0, 1);
            PG8_WAIT_V(8); PG8_WAIT_L(0); PG8_BAR; PG8_MMA(1, 0, At, B0); PG8_MMA(1, 1, At, B1); PG8_BAR; PG8_SCHED;
            PG8_LDB(B0, 1, 0); PG8_LDB(B1, 1, 1); PG8_SCHED; PG8_LDA(At, 1, 0); PG8_STAGE_A(PG8_SA(0, 1), a2, 1);
            PG8_WAIT_V(8); PG8_WAIT_L(0); PG8_BAR; PG8_MMA(0, 0, At, B0); PG8_MMA(0, 1, At, B1); PG8_BAR; PG8_SCHED;
            PG8_STAGE(PG8_SB(1, 0), b3, voffB); PG8_STAGE(PG8_SB(1, 1), b3 + hstepB, voffB); PG8_STAGE_A(PG8_SA(1, 0), a3, 0); PG8_LDA(At, 1, 1);
            PG8_WAIT_V(8); PG8_WAIT_L(0); PG8_BAR; PG8_MMA(1, 0, At, B0); PG8_MMA(1, 1, At, B1); PG8_BAR; PG8_SCHED;
        }
        if constexpr (ALIGN_EPI) { if (wr == 0) PG8_BAR; }
        { int fr_e = fr, fq_e = fq; asm volatile("" : "+v"(fr_e), "+v"(fq_e));
          cur.slot = ui % 3; E(acc, cur, wr, wc, fr_e, fq_e, pre); }
        if (!has_next) break;
        if (!(Sched::CHAIN && cur.seg == 0)) {
#pragma unroll
        for (int a = 0; a < 2; ++a)
#pragma unroll
            for (int b = 0; b < 2; ++b)
#pragma unroll
                for (int m = 0; m < 4; ++m)
#pragma unroll
                    for (int n = 0; n < 2; ++n) { typedef unsigned long long u64x2 __attribute__((ext_vector_type(2))); u64x2 z;
                    asm volatile("v_mov_b64 %0, 0" : "=v"(z.x)); asm volatile("v_mov_b64 %0, 0" : "=v"(z.y)); acc[a][b][m][n] = __builtin_bit_cast(f32x4, z); }
        }
        cur = nxt; cA = nA; cB = nB; ++ui;
        pre = E.prefetch(cur, wr, wc, fr, fq);
        if constexpr (ALIGN_EPI) { if (wr == 1) PG8_BAR; }
    }
    PG8_WAIT_V(0);
    if constexpr (!ALIGN_EPI) { if (wr == 0) PG8_BAR; }
    PG8_BAR;
#undef PG8_SA
#undef PG8_SB
#undef PG8_STAGE
#undef PG8_STAGE_A
#undef PG8_LDA
#undef PG8_LDB
#undef PG8_MMA
#undef PG8_LD8
#undef PG8_HALF
#undef PG8_WAIT_V
#undef PG8_WAIT_L
#undef PG8_BAR
#undef PG8_SCHED
}
}
using pg8::Unit;

constexpr size_t MiB = 1u << 20;
constexpr size_t WS_CTL = 0, CTL_ZERO_BYTES = 64 * 1024;
constexpr int IN_BF_TILES = 6;
constexpr size_t WS_WIN = 2 * MiB;
constexpr size_t WS_WIN8 = 6 * MiB;
constexpr size_t WS_WGLU = 13 * MiB;
constexpr size_t WS_WCAT = 14 * MiB;
constexpr size_t WS_WOUT = 17 * MiB;
constexpr size_t WS_ROPE = 19 * MiB;
constexpr size_t WS_BTY = 35 * MiB;
constexpr size_t WS_BTV = 55 * MiB;
constexpr size_t WS_DBUF = 63 * MiB;
constexpr size_t WS_W1 = 64 * MiB;
constexpr size_t WS_W2 = 192 * MiB;
constexpr size_t WS_H = 256 * MiB;
constexpr size_t WS_Z = 256 * MiB, WS_YS5 = 288 * MiB;
constexpr size_t WS_AS5 = 320 * MiB;
constexpr size_t WS_VBUF = 360 * MiB;
constexpr size_t WS_Q = 376 * MiB, WS_K = 408 * MiB, WS_V = 440 * MiB;
constexpr size_t WS_GS = 536 * MiB, WS_SA = 600 * MiB, WS_SB = 664 * MiB;
constexpr size_t WS_KV = 728 * MiB;
constexpr size_t WS_ST = 856 * MiB;
constexpr size_t WS_RETG = 920 * MiB;
constexpr size_t WS_H8 = 984 * MiB;
constexpr size_t WS_MERGED = 440 * MiB;
constexpr size_t WS_H2 = 256 * MiB;
constexpr size_t WS_XS = 320 * MiB;
constexpr size_t WS_YK = 320 * MiB;
constexpr size_t WS_ACT = 592 * MiB;
constexpr size_t WS_ETOK = 864 * MiB, WS_INV = 872 * MiB, WS_GATE4 = 873 * MiB;
constexpr size_t WS_X1 = 728 * MiB;
constexpr size_t WS_ROWSS = 876 * MiB;
constexpr size_t WS_END = 1024 * MiB;
static_assert(WS_RETG + 64 * MiB <= WS_END && WS_ACT + (size_t)MAXROWS * 2048 <= WS_ETOK && WS_XS + (size_t)MAXROWS * 2048 <= WS_ACT, "d_ws map");
constexpr int CW_ECNT = 64;
constexpr int CW_QUEUE = 2112;
constexpr int CW_BAR = 4096;

constexpr int RING_BYTES = 131072;
constexpr int LDSCTL_OFF = RING_BYTES;
constexpr int LDS_TILEE = LDSCTL_OFF + 256;
constexpr int LDS_P8 = LDSCTL_OFF + 1024;
constexpr int LDS_PST = LDSCTL_OFF + 12288, LDS_CNT = LDSCTL_OFF + 12288 + 256;
constexpr int LDS_BYTES = 147456;

#define XB_TMO      128
#define XB_XCNT(j)  (256  + 64 * (j))
#define XB_XSUB(j)  (1280 + 64 * (j))
#define XB_XGEN(j)  (2304 + 64 * (j))
#define XB_TOP      3328
#define XB_TOPGEN   3392
#define XCD_BAR_WORDS 3456
#define XB_SPIN_CAP (1u << 18)
__device__ __forceinline__ unsigned xb_ld(unsigned* p)              { return __hip_atomic_load(p, __ATOMIC_RELAXED, __HIP_MEMORY_SCOPE_AGENT); }
__device__ __forceinline__ unsigned xb_add(unsigned* p, unsigned v) { return __hip_atomic_fetch_add(p, v, __ATOMIC_RELAXED, __HIP_MEMORY_SCOPE_AGENT); }
__device__ __forceinline__ unsigned xb_xcc_id() { return (unsigned)__builtin_amdgcn_s_getreg((3 << 11) | 20) & 0xFu; }
#define XB_SPIN(cond, bar) do { unsigned _sp = 0; while (cond) { __builtin_amdgcn_s_sleep(1); \
    if ((++_sp & 255u) == 0u) { if (xb_ld(&(bar)[XB_TMO])) break; if (_sp > XB_SPIN_CAP) { atomicAdd(&(bar)[XB_TMO], 1u); break; } } } } while (0)
struct XcdBarrier { unsigned* bar; unsigned x; volatile LAS unsigned* st; };
__device__ __forceinline__ XcdBarrier xcd_barrier_post(unsigned* bar, volatile LAS unsigned* st) {
    XcdBarrier b; b.bar = bar; b.x = xb_xcc_id(); b.st = st;
    if (threadIdx.x == 0) (void)xb_add(&bar[XB_XCNT(b.x)], 1u);
    return b;
}
__device__ __forceinline__ void xcd_barrier_complete(unsigned* bar, unsigned x, unsigned& nloc, unsigned& nx) {
    const unsigned G = gridDim.x * gridDim.y * gridDim.z;
    unsigned sum, cnt, mine, sp = 0u;
    for (;;) {
        sum = 0u; cnt = 0u; mine = 0u;
#pragma unroll
        for (unsigned j = 0; j < 16; ++j) { const unsigned c = xb_ld(&bar[XB_XCNT(j)]); sum += c; cnt += (c > 0u) ? 1u : 0u; mine = (j == x) ? c : mine; }
        if (sum == G) break;
        __builtin_amdgcn_s_sleep(1);
        if ((++sp & 255u) == 0u) { if (xb_ld(&bar[XB_TMO])) break; if (sp > XB_SPIN_CAP) { atomicAdd(&bar[XB_TMO], 1u); break; } }
    }
    nloc = mine > 0u ? mine : 1u; nx = cnt > 0u ? cnt : 1u;
}
__device__ __forceinline__ void xcd_barrier(const XcdBarrier& b) {
    asm volatile("s_waitcnt vmcnt(0)" ::: "memory");
    __syncthreads();
    if (threadIdx.x == 0) {
        unsigned* bar = b.bar;
        __builtin_amdgcn_s_waitcnt(0);
        unsigned nloc = b.st[0], nx = b.st[1];
        if (nloc == 0u) { xcd_barrier_complete(bar, b.x, nloc, nx); b.st[0] = nloc; b.st[1] = nx; }
        const unsigned old = xb_add(&bar[XB_XSUB(b.x)], 1u);
        const unsigned gen = old / nloc;
        if (old + 1u == (gen + 1u) * nloc) {
            __builtin_amdgcn_fence(__ATOMIC_RELEASE, "agent");
            asm volatile("s_waitcnt vmcnt(0)" ::: "memory");
            const unsigned og = xb_add(&bar[XB_TOP], 1u);
            const unsigned tg = og / nx;
            if (og + 1u == (tg + 1u) * nx) xb_add(&bar[XB_TOPGEN], 1u);
            else XB_SPIN(xb_ld(&bar[XB_TOPGEN]) == tg, bar);
            __builtin_amdgcn_fence(__ATOMIC_ACQUIRE, "agent");
            xb_add(&bar[XB_XGEN(b.x)], 1u);
            asm volatile("s_waitcnt vmcnt(0)" ::: "memory");
        } else {
            XB_SPIN(xb_ld(&bar[XB_XGEN(b.x)]) == gen, bar);
            __builtin_amdgcn_fence(__ATOMIC_ACQUIRE, "agent");
            asm volatile("s_waitcnt vmcnt(0)" ::: "memory");
        }
    }
    __syncthreads();
}

constexpr int NWAVES = 8, NTHREADS = NWAVES * 64;
struct Frame {
    LAS unsigned char* lds;
    unsigned* ctl;
    int wave, vcu, G;
    unsigned char* ws;
    float* out;
};
enum { I_X = 0, I_POS, I_NMG, I_WIN, I_LRE, I_LIM, I_LDT, I_BRE, I_BIM, I_CRE, I_CIM, I_D, I_WGLU, I_BGLU, I_GNG, I_WBS5, I_WBRET, I_WOUT, I_NFG, I_RW, I_RB, I_W1, I_B1, I_W2, I_B2, I_NFIN };

__device__ __forceinline__ const float* inp(int i) {
    typedef const float* const __attribute__((address_space(4))) * kptr_t;
    kptr_t p = (kptr_t)__builtin_amdgcn_kernarg_segment_ptr(); asm volatile("" : "+s"(p)); return p[i];
}

__device__ __forceinline__ int otid() { int t = threadIdx.x; asm volatile("" : "+v"(t)); return t; }

__device__ __forceinline__ void sincos_d(double x, double& s, double& c) {
    const double n = __builtin_rint(x * 0.63661977236758134308);
    double r = __builtin_fma(-n, 1.57079632679489655800e+00, x);
    r = __builtin_fma(-n, 6.12323399573676603587e-17, r);
    const double r2 = r * r;
    double ps = -1.0 / 1307674368000.0;
    ps = __builtin_fma(ps, r2, 1.0 / 6227020800.0); ps = __builtin_fma(ps, r2, -1.0 / 39916800.0); ps = __builtin_fma(ps, r2, 1.0 / 362880.0);
    ps = __builtin_fma(ps, r2, -1.0 / 5040.0); ps = __builtin_fma(ps, r2, 1.0 / 120.0); ps = __builtin_fma(ps, r2, -1.0 / 6.0);
    const double sr = __builtin_fma(ps * r2, r, r);
    double pc = 1.0 / 20922789888000.0;
    pc = __builtin_fma(pc, r2, -1.0 / 87178291200.0); pc = __builtin_fma(pc, r2, 1.0 / 479001600.0); pc = __builtin_fma(pc, r2, -1.0 / 3628800.0);
    pc = __builtin_fma(pc, r2, 1.0 / 40320.0); pc = __builtin_fma(pc, r2, -1.0 / 720.0); pc = __builtin_fma(pc, r2, 1.0 / 24.0); pc = __builtin_fma(pc, r2, -0.5);
    const double cr = __builtin_fma(pc, r2, 1.0);
    const int q = ((int)n) & 3;
    s = (q == 0) ? sr : (q == 1) ? cr : (q == 2) ? -sr : -cr;
    c = (q == 0) ? cr : (q == 1) ? -sr : (q == 2) ? -cr : sr;
}
__device__ __forceinline__ double exp_d(double x) {
    const double k = __builtin_rint(x * 1.44269504088896338700);
    double r = __builtin_fma(-k, 6.93147180369123816490e-01, x);
    r = __builtin_fma(-k, 1.90821492927058770002e-10, r);
    double p = 1.0 / 6227020800.0;
    p = __builtin_fma(p, r, 1.0 / 479001600.0); p = __builtin_fma(p, r, 1.0 / 39916800.0); p = __builtin_fma(p, r, 1.0 / 3628800.0); p = __builtin_fma(p, r, 1.0 / 362880.0);
    p = __builtin_fma(p, r, 1.0 / 40320.0); p = __builtin_fma(p, r, 1.0 / 5040.0); p = __builtin_fma(p, r, 1.0 / 720.0); p = __builtin_fma(p, r, 1.0 / 120.0);
    p = __builtin_fma(p, r, 1.0 / 24.0); p = __builtin_fma(p, r, 1.0 / 6.0); p = __builtin_fma(p, r, 0.5); p = __builtin_fma(p, r, 1.0); p = __builtin_fma(p, r, 1.0);
    const long long bits = ((long long)((int)k + 1023)) << 52;
    return p * __builtin_bit_cast(double, bits);
}

__device__ __forceinline__ void p0_load_item(const float* W, int N, int k0, int n0, LAS float* scr, int lane) {
    const int kq = lane >> 3, n4 = (lane & 7) * 4; f32x4 v[8];
#pragma unroll
    for (int i = 0; i < 8; ++i) v[i] = __builtin_nontemporal_load((const f32x4*)(W + (size_t)(k0 + 8 * i + kq) * N + n0 + n4));
#pragma unroll
    for (int i = 0; i < 8; ++i) { LAS float* d = scr + (8 * i + kq) * 33 + n4; d[0] = v[i].x; d[1] = v[i].y; d[2] = v[i].z; d[3] = v[i].w; }
    LDS_WAIT(); asm volatile("" ::: "memory");
}
template <bool QKPERM>
__device__ __forceinline__ void p0_transpose_item(const float* W, int K, int N, bf16_t* WT, LAS float* scr, int item, int lane, int ldw) {
    const int nblk = N / 32, kb = item / nblk, nb = item % nblk, k0 = 64 * kb, n0 = 32 * nb;
    p0_load_item(W, N, k0, n0, scr, lane);
    const int c = lane & 7;
#pragma unroll
    for (int j = 0; j < 4; ++j) { const int n = (lane >> 3) + 8 * j; const LAS float* s = scr + (8 * c) * 33 + n;
        u32x4 o; o.x = pkbf(s[0 * 33], s[1 * 33]); o.y = pkbf(s[2 * 33], s[3 * 33]); o.z = pkbf(s[4 * 33], s[5 * 33]); o.w = pkbf(s[6 * 33], s[7 * 33]);
        int nd = n0 + n;
        if (QKPERM) { if (nd >= 512 && nd < 1536) { const int d = nd & 127; const int p = (d < 64) ? (8 * (d >> 2) + (d & 3)) : (8 * ((d - 64) >> 2) + 4 + (d & 3)); nd = (nd & ~127) + p; } }
        *(u32x4*)(WT + (size_t)nd * ldw + k0 + 8 * c) = o; }
    LDS_WAIT(); asm volatile("" ::: "memory");
}

template <int MODE>
__device__ __forceinline__ void p0_transpose_item_fp8(const float* W, int K, int N, unsigned char* WT, LAS float* scr, int item, int lane) {
    const int nblk = N / 32, kb = item / nblk, nb = item % nblk, k0 = 64 * kb, n0 = 32 * nb;
    p0_load_item(W, N, k0, n0, scr, lane);
    const int c = lane & 7;
#pragma unroll
    for (int j = 0; j < 4; ++j) { const int n = (lane >> 3) + 8 * j; const LAS float* s = scr + (8 * c) * 33 + n;
        u32x2 o; o.x = pkfp8x4(32.f * s[0 * 33], 32.f * s[1 * 33], 32.f * s[2 * 33], 32.f * s[3 * 33]); o.y = pkfp8x4(32.f * s[4 * 33], 32.f * s[5 * 33], 32.f * s[6 * 33], 32.f * s[7 * 33]);
        int nd = n0 + n; if (MODE == 1) { const int jj = nd >> 1; nd = 256 * (jj >> 7) + 128 * (nd & 1) + (jj & 127); }
        if (MODE == 2) nd -= 256 * IN_BF_TILES;
        if (MODE == 3) { const int L = nd & 255; nd = (nd & ~255) + 128 * ((L >> 3) & 1) + 32 * (L >> 6) + 8 * ((L >> 4) & 3) + (L & 7); }
        __builtin_nontemporal_store(o, (u32x2*)(WT + (size_t)nd * K + k0 + 8 * c)); }
    LDS_WAIT(); asm volatile("" ::: "memory");
}

__device__ __forceinline__ void p0_s5_group(Frame& F, int g, int part) {
    const int tid_o = otid();
    LAS float* PW = (LAS float*)(F.lds);
    LAS float* BP = (LAS float*)(F.lds + 17408);
    LAS float* CC = (LAS float*)(F.lds + 25600);
    LAS float* KD = (LAS float*)(F.lds + 33792);
    LAS float* FF = (LAS float*)(F.lds + 66560);
    const int tid = tid_o;
    if (tid < 64) {
        const int n = tid;
        const double lr = (double)inp(I_LRE)[g * 64 + n], li = (double)inp(I_LIM)[g * 64 + n], dt = exp_d((double)inp(I_LDT)[g]);
        const double mag = exp_d(lr * dt); double sn, cs; sincos_d(li * dt, sn, cs);
        const double ar = mag * cs, aim = mag * sn;
        const double nr = ar - 1.0, ni = aim, den = lr * lr + li * li;
        FF[2 * n] = (float)((nr * lr + ni * li) / den); FF[2 * n + 1] = (float)((ni * lr - nr * li) / den);
        double pr = 1.0, pi = 0.0;
        for (int d = 0; d <= 32; ++d) { PW[(d * 64 + n) * 2] = (float)pr; PW[(d * 64 + n) * 2 + 1] = (float)pi; const double t = pr * ar - pi * aim; pi = pr * aim + pi * ar; pr = t; }
        if (part == 0) { float* db = (float*)(F.ws + WS_DBUF) + (g * 64 + n) * 2; db[0] = PW[(32 * 64 + n) * 2]; db[1] = PW[(32 * 64 + n) * 2 + 1]; }
    }
    __syncthreads();
    for (int i = tid; i < 1024; i += NTHREADS) {
        const int n = i >> 4, c = i & 15; const float br = inp(I_BRE)[(g * 64 + n) * 16 + c], bi = inp(I_BIM)[(g * 64 + n) * 16 + c], fr = FF[2 * n], fi = FF[2 * n + 1];
        BP[i * 2] = fr * br - fi * bi; BP[i * 2 + 1] = fr * bi + fi * br;
        const int c2 = i >> 6, n2 = i & 63; CC[i * 2] = inp(I_CRE)[(g * 16 + c2) * 64 + n2]; CC[i * 2 + 1] = inp(I_CIM)[(g * 16 + c2) * 64 + n2];
    }
    __syncthreads();
    for (int i = tid; i < 2048; i += NTHREADS) {
        const int d = i >> 6, c = 4 * part + ((i >> 4) & 3), cp = i & 15; float a = 0.f;
        for (int n = 0; n < 64; ++n) {
            const f32x2 cv = *(const LAS f32x2*)(CC + (c * 64 + n) * 2), pv = *(const LAS f32x2*)(PW + (d * 64 + n) * 2), bv = *(const LAS f32x2*)(BP + (n * 16 + cp) * 2);
            const float tr = cv.x * pv.x - cv.y * pv.y, ti = cv.x * pv.y + cv.y * pv.x;
            a += tr * bv.x - ti * bv.y;
        }
        KD[i] = a;
    }
    __syncthreads();
    bf16_t* BtY = (bf16_t*)(F.ws + WS_BTY) + (size_t)g * 512 * 640;
    for (int id = tid; id < 128 * 80; id += NTHREADS) {
        const int rl = id / 80, ch = id % 80, t = rl >> 2, cl = rl & 3, c = 4 * part + cl, row = t * 16 + c; float v[8];
        if (ch < 64) { const int j = ch >> 1, cp0 = (ch & 1) * 8;
#pragma unroll
            for (int q = 0; q < 8; ++q) v[q] = (j <= t) ? KD[((t - j) * 4 + cl) * 16 + cp0 + q] : 0.f;
        } else { const int nn0 = (ch - 64) * 8;
#pragma unroll
            for (int q = 0; q < 8; ++q) { const int nn = nn0 + q, n = nn & 63; const f32x2 cv = *(const LAS f32x2*)(CC + (c * 64 + n) * 2), pv = *(const LAS f32x2*)(PW + ((t + 1) * 64 + n) * 2);
                v[q] = (nn < 64) ? (cv.x * pv.x - cv.y * pv.y) : -(cv.x * pv.y + cv.y * pv.x); }
        }
        u32x4 o; o.x = pkbf(v[0], v[1]); o.y = pkbf(v[2], v[3]); o.z = pkbf(v[4], v[5]); o.w = pkbf(v[6], v[7]);
        *(u32x4*)(BtY + (size_t)row * 640 + ch * 8) = o;
    }
    bf16_t* BtV = (bf16_t*)(F.ws + WS_BTV) + (size_t)g * 256 * 512;
    for (int id = tid; id < 64 * 64; id += NTHREADS) {
        const int row = 64 * part + (id >> 6), ch = id & 63, j = ch >> 1, cp0 = (ch & 1) * 8, n = row & 63; float v[8];
#pragma unroll
        for (int q = 0; q < 8; ++q) { const f32x2 pv = *(const LAS f32x2*)(PW + ((31 - j) * 64 + n) * 2), bv = *(const LAS f32x2*)(BP + (n * 16 + cp0 + q) * 2);
            v[q] = (row < 64) ? (pv.x * bv.x - pv.y * bv.y) : (row < 128) ? (pv.x * bv.y + pv.y * bv.x) : 0.f; }
        u32x4 o; o.x = pkbf(v[0], v[1]); o.y = pkbf(v[2], v[3]); o.z = pkbf(v[4], v[5]); o.w = pkbf(v[6], v[7]);
        *(u32x4*)(BtV + (size_t)row * 512 + ch * 8) = o;
    }
    __syncthreads();
}

__device__ __forceinline__ int p0_grab(unsigned* ctr, int n) { int v = 0; if ((otid() & 63) == 0) v = (int)__hip_atomic_fetch_add(ctr, (unsigned)n, __ATOMIC_RELAXED, __HIP_MEMORY_SCOPE_AGENT); return __builtin_amdgcn_readfirstlane(v); }
__device__ __forceinline__ void p0_prologue(Frame& F) {
    const int tid_o = otid(), lane_o = tid_o & 63;
    for (int it = blockIdx.x; it < 4 * S5G; it += F.G) p0_s5_group(F, it >> 2, it & 3);
    const int gw = F.vcu * NWAVES + F.wave, NGW = F.G * NWAVES;
    {
        const int* pos = (const int*)inp(I_POS); float* rope = (float*)(F.ws + WS_ROPE);
        const int gt = F.vcu * NTHREADS + tid_o, NGT = F.G * NTHREADS;
        for (int i = gt; i < T * 64; i += NGT) {
            const int tok = i >> 6, dh = i & 63;
            double f = 1.0; { double b = 0.86596432336006535; int e = dh; while (e) { if (e & 1) f *= b; b *= b; e >>= 1; } }
            double s, c; sincos_d((double)pos[tok] * f, s, c);
            rope[(size_t)tok * 128 + dh] = (float)c; rope[(size_t)tok * 128 + 64 + dh] = (float)s;
        }
    }
    {
        const float* gg = inp(I_NMG); f32x4 gv[4];
#pragma unroll
        for (int j = 0; j < 4; ++j) gv[j] = *((const f32x4*)gg + lane_o + 64 * j);
        for (int m = gw; m < T; m += NGW) {
            const f32x4* xr = (const f32x4*)(inp(I_X) + (size_t)m * DM) + lane_o; f32x4 v[4]; float s = 0.f;
#pragma unroll
            for (int j = 0; j < 4; ++j) { v[j] = __builtin_nontemporal_load(xr + 64 * j); s += (v[j].x * v[j].x + v[j].y * v[j].y) + (v[j].z * v[j].z + v[j].w * v[j].w); }
            const float rs = 1.0f / sqrtf(wave_sum(s) * (1.f / DM) + NORM_EPS);
            u32x2* o8 = (u32x2*)((bf16_t*)(F.ws + WS_H) + (size_t)m * DM) + lane_o;
            unsigned* o4 = (unsigned*)((unsigned char*)(F.ws + WS_H8) + (size_t)m * DM) + lane_o;
#pragma unroll
            for (int j = 0; j < 4; ++j) { const f32x4 hh = v[j] * rs * gv[j]; u32x2 o; o.x = pkbf(hh.x, hh.y); o.y = pkbf(hh.z, hh.w); o8[64 * j] = o; o4[64 * j] = pkfp8x4(hh.x, hh.y, hh.z, hh.w); }
        }
    }
    LAS float* scr = (LAS float*)(F.lds + F.wave * 16384);
    constexpr int I_IN = (DM / 64) * (INW / 32), I_GLU = (512 / 64) * (512 / 32), I_BS5 = (512 / 64) * (1024 / 32), I_SQ = (1024 / 64) * (1024 / 32);
    constexpr int I_E1 = (1024 / 64) * (2048 / 32), I_E2 = I_SQ;
    constexpr int NITEMS = I_IN + I_GLU + I_BS5 + 2 * I_SQ + NE * (I_E1 + I_E2), CHUNK = 8;
    unsigned* qctr = F.ctl + CW_QUEUE;
    int base = p0_grab(qctr, CHUNK);
    while (base < NITEMS) {
        const int nbase = p0_grab(qctr, CHUNK);
        const int end = (base + CHUNK < NITEMS) ? base + CHUNK : NITEMS;
        for (int it = base; it < end; ++it) {
            int r = it;
            if (r < NE * I_E1) { const int e = r / I_E1; p0_transpose_item_fp8<1>(inp(I_W1) + (size_t)e * 1024 * 2048, 1024, 2048, (unsigned char*)(F.ws + WS_W1) + (size_t)e * 2048 * 1024, scr, r % I_E1, lane_o); continue; } r -= NE * I_E1;
            if (r < NE * I_E2) { const int e = r / I_E2; p0_transpose_item_fp8<3>(inp(I_W2) + (size_t)e * 1024 * 1024, 1024, 1024, (unsigned char*)(F.ws + WS_W2) + (size_t)e * 1024 * 1024, scr, r % I_E2, lane_o); continue; } r -= NE * I_E2;
            if (r < I_IN) { if ((r % (INW / 32)) < 256 * IN_BF_TILES / 32) p0_transpose_item<true>(inp(I_WIN), DM, INW, (bf16_t*)(F.ws + WS_WIN), scr, r, lane_o, DM);
                            else p0_transpose_item_fp8<2>(inp(I_WIN), DM, INW, (unsigned char*)(F.ws + WS_WIN8), scr, r, lane_o); continue; } r -= I_IN;
            if (r < I_GLU) { p0_transpose_item<false>(inp(I_WGLU), 512, 512, (bf16_t*)(F.ws + WS_WGLU), scr, r, lane_o, 512); continue; } r -= I_GLU;
            if (r < I_BS5) { p0_transpose_item<false>(inp(I_WBS5), 512, 1024, (bf16_t*)(F.ws + WS_WCAT), scr, r, lane_o, 1536); continue; } r -= I_BS5;
            if (r < I_SQ) { p0_transpose_item<false>(inp(I_WBRET), 1024, 1024, (bf16_t*)(F.ws + WS_WCAT) + 512, scr, r, lane_o, 1536); continue; } r -= I_SQ;
            p0_transpose_item<false>(inp(I_WOUT), 1024, 1024, (bf16_t*)(F.ws + WS_WOUT), scr, r, lane_o, 1024);
        }
        base = nbase;
    }
}

typedef const f32x4 (&AccRef)[2][2][4][2];
struct Pre0 {};
struct Pre16 { f32x4 v[4]; };
#define EPI_ROWS(...) _Pragma("unroll") for (int ai = 0; ai < 2; ++ai) { _Pragma("unroll") for (int m = 0; m < 4; ++m) { const int rloc = ai * 128 + wr * 64 + m * 16 + fr; _Pragma("unroll") for (int bj = 0; bj < 2; ++bj) { const int cloc = bj * 128 + wc * 32 + 8 * fq; const f32x4 v0 = acc[ai][bj][m][0], v1 = acc[ai][bj][m][1]; __VA_ARGS__ } } asm volatile("" ::: "memory"); }

__device__ __forceinline__ float l2gamma(int h) { return h == 0 ? -0.04580368961312479f : h == 1 ? -0.02272007650008353f : h == 2 ? -0.011315313227834146f : -0.005646563141142063f; }

template <bool GATES> struct EpiInProj {
    static constexpr bool PERM = true, FP8 = GATES;
    unsigned char* ws;
    typedef Pre0 Pre; __device__ __forceinline__ Pre prefetch(const Unit&, int, int, int, int) const { return Pre(); }
    __device__ __forceinline__ void operator()(AccRef acc, const Unit& u, int wr, int wc, int fr, int fq, const Pre&) const {
        const int ct = u.pn + (GATES ? IN_BF_TILES : 0); constexpr int LO = GATES ? IN_BF_TILES : 0, HI = GATES ? 22 : IN_BF_TILES;
        if (LO < 2 && ct < 2) {
            bf16_t* AS5 = (bf16_t*)(ws + WS_AS5);
            EPI_ROWS({ const int row = u.pm * 256 + rloc, col = ct * 256 + cloc, g = col >> 4, c0 = col & 15, b = row >> 13, t = row & 8191;
                u32x4 o; o.x = pkbf(v0[0], v0[1]); o.y = pkbf(v0[2], v0[3]); o.z = pkbf(v1[0], v1[1]); o.w = pkbf(v1[2], v1[3]);
                *(u32x4*)(AS5 + ((size_t)(g * 1024 + b * 256 + (t >> 5)) * 640 + (t & 31) * 16 + c0)) = o; })
        } else if (LO < 6 && HI > 2 && ct < 6) {
            const bool isk = ct >= 4; const float* rope = (const float*)(ws + WS_ROPE);
            bf16_t* QK = (bf16_t*)(ws + (isk ? WS_K : WS_Q));
            const int p0 = wc * 32 + 8 * fq, dh0 = p0 >> 1;
#pragma unroll
            for (int ai = 0; ai < 2; ++ai) { f32x4 cs[4], sn[4];
#pragma unroll
                for (int m = 0; m < 4; ++m) { const int row = u.pm * 256 + ai * 128 + wr * 64 + m * 16 + fr; cs[m] = *(const f32x4*)(rope + (size_t)row * 128 + dh0); sn[m] = *(const f32x4*)(rope + (size_t)row * 128 + 64 + dh0); }
#pragma unroll
                for (int m = 0; m < 4; ++m) { const int row = u.pm * 256 + ai * 128 + wr * 64 + m * 16 + fr; const float e = (float)((row & 127) + 1);
#pragma unroll
                    for (int bj = 0; bj < 2; ++bj) { const int hh = ((ct & 1) << 1) + bj; const float lg = l2gamma(hh); const f32x4 v0 = acc[ai][bj][m][0], v1 = acc[ai][bj][m][1];
                        const float sc = isk ? __builtin_amdgcn_exp2f(-lg * e) * 0.08838834764831845f : __builtin_amdgcn_exp2f(lg * e);
                        const f32x4 o1 = (v0 * cs[m] - v1 * sn[m]) * sc, o2 = (v1 * cs[m] + v0 * sn[m]) * sc;
                        u32x4 o; o.x = pkbf(o1[0], o1[1]); o.y = pkbf(o1[2], o1[3]); o.z = pkbf(o2[0], o2[1]); o.w = pkbf(o2[2], o2[3]);
                        *(u32x4*)(QK + (size_t)row * 512 + hh * 128 + p0) = o; } }
                asm volatile("" ::: "memory"); }
        } else if (LO < 10 && HI > 6 && ct < 10) {
            bf16_t* V = (bf16_t*)(ws + WS_V);
            EPI_ROWS({ const int row = u.pm * 256 + rloc, col = (ct - 6) * 256 + cloc;
                u32x4 o; o.x = pkbf(v0[0], v0[1]); o.y = pkbf(v0[2], v0[3]); o.z = pkbf(v1[0], v1[1]); o.w = pkbf(v1[2], v1[3]);
                *(u32x4*)(V + (size_t)row * 1024 + col) = o; })
        } else if (HI > 10) {
            const bool is_silu = ct < 14; bf16_t* SG = (bf16_t*)(ws + (ct < 14 ? WS_GS : ct < 18 ? WS_SA : WS_SB)); const int cb = ((ct - 10) & 3) * 256;
            if (is_silu) {
                EPI_ROWS({ const int row = u.pm * 256 + rloc, col = cb + cloc; f32x4 a0 = v0, a1 = v1; asm volatile("" : "+v"(a0), "+v"(a1));
                    const f32x2 x0 = {a0[0], a0[1]}, x1 = {a0[2], a0[3]}, x2 = {a1[0], a1[1]}, x3 = {a1[2], a1[3]};
                    const f32x2 y0 = x0 * fsigmoid2(x0), y1 = x1 * fsigmoid2(x1), y2 = x2 * fsigmoid2(x2), y3 = x3 * fsigmoid2(x3);
                    u32x4 o; o.x = pkbf(y0.x, y0.y); o.y = pkbf(y1.x, y1.y); o.z = pkbf(y2.x, y2.y); o.w = pkbf(y3.x, y3.y);
                    __builtin_nontemporal_store(o, (u32x4*)(SG + (size_t)row * 1024 + col)); })
            } else {
                EPI_ROWS({ const int row = u.pm * 256 + rloc, col = cb + cloc; f32x4 a0 = v0, a1 = v1; asm volatile("" : "+v"(a0), "+v"(a1));
                    const f32x2 y0 = fsigmoid2(f32x2{a0[0], a0[1]}), y1 = fsigmoid2(f32x2{a0[2], a0[3]}), y2 = fsigmoid2(f32x2{a1[0], a1[1]}), y3 = fsigmoid2(f32x2{a1[2], a1[3]});
                    u32x4 o; o.x = pkbf(y0.x, y0.y); o.y = pkbf(y1.x, y1.y); o.z = pkbf(y2.x, y2.y); o.w = pkbf(y3.x, y3.y);
                    __builtin_nontemporal_store(o, (u32x4*)(SG + (size_t)row * 1024 + col)); })
            }
        }
    }
};

struct EpiS5V {
    static constexpr bool PERM = false, FP8 = false;
    float* VB;
    typedef Pre0 Pre; __device__ __forceinline__ Pre prefetch(const Unit&, int, int, int, int) const { return Pre(); }
    __device__ __forceinline__ void operator()(AccRef acc, const Unit& u, int wr, int wc, int fr, int fq, const Pre&) const {
#pragma unroll
        for (int ai = 0; ai < 2; ++ai)
#pragma unroll
            for (int m = 0; m < 4; ++m) { const int r = u.pm * 256 + ai * 128 + wr * 64 + m * 16 + fr; float* rp = VB + ((size_t)(u.aux * 1024 + r)) * 128 + wc * 32 + 4 * fq;
#pragma unroll
                for (int n = 0; n < 2; ++n) *(f32x4*)(rp + n * 16) = acc[ai][0][m][n]; }
    }
};

struct EpiS5Y {
    static constexpr bool PERM = true, FP8 = false;
    const bf16_t* AS5; bf16_t* Z; const float* dsk;
    typedef Pre0 Pre; __device__ __forceinline__ Pre prefetch(const Unit&, int, int, int, int) const { return Pre(); }
    __device__ __forceinline__ void operator()(AccRef acc, const Unit& u, int wr, int wc, int fr, int fq, const Pre&) const {
        const int g = u.aux;
        EPI_ROWS({ const int r = u.pm * 256 + rloc, col = u.pn * 256 + cloc, b = r >> 8, ch = r & 255, tl = col >> 4, c0 = col & 15, tok = b * 8192 + ch * 32 + tl;
            const u32x4 uu = *(const u32x4*)(AS5 + ((size_t)(g * 1024 + r)) * 640 + col);
            const f32x4 d0 = *(const f32x4*)(dsk + g * 16 + c0), d1 = *(const f32x4*)(dsk + g * 16 + c0 + 4);
            f32x2 y[4] = { f32x2{v0[0], v0[1]} + f32x2{d0[0], d0[1]} * f32x2{bflo(uu.x), bfhi(uu.x)}, f32x2{v0[2], v0[3]} + f32x2{d0[2], d0[3]} * f32x2{bflo(uu.y), bfhi(uu.y)},
                           f32x2{v1[0], v1[1]} + f32x2{d1[0], d1[1]} * f32x2{bflo(uu.z), bfhi(uu.z)}, f32x2{v1[2], v1[3]} + f32x2{d1[2], d1[3]} * f32x2{bflo(uu.w), bfhi(uu.w)} };
            _Pragma("unroll") for (int q = 0; q < 4; ++q) { const f32x2 a = (y[q] + (y[q] * y[q]) * y[q] * 0.044715f) * 0.7978845608028654f; y[q] = y[q] * fsigmoid2(a * 2.0f); }
            u32x4 o; o.x = pkbf(y[0].x, y[0].y); o.y = pkbf(y[1].x, y[1].y); o.z = pkbf(y[2].x, y[2].y); o.w = pkbf(y[3].x, y[3].y);
            *(u32x4*)(Z + (size_t)tok * 512 + g * 16 + c0) = o; })
    }
};

struct EpiGlu {
    static constexpr bool PERM = true, FP8 = false;
    const bf16_t* Z; bf16_t* Y; const float* bg;
    typedef Pre0 Pre; __device__ __forceinline__ Pre prefetch(const Unit&, int, int, int, int) const { return Pre(); }
    __device__ __forceinline__ void operator()(AccRef acc, const Unit& u, int wr, int wc, int fr, int fq, const Pre&) const {
        EPI_ROWS({ const int row = u.pm * 256 + rloc, col = u.pn * 256 + cloc;
            const u32x4 zz = __builtin_nontemporal_load((const u32x4*)(Z + (size_t)row * 512 + col)); const f32x4 b0 = *(const f32x4*)(bg + col), b1 = *(const f32x4*)(bg + col + 4);
            const f32x2 y0 = f32x2{bflo(zz.x), bfhi(zz.x)} * fsigmoid2(f32x2{v0[0], v0[1]} + f32x2{b0[0], b0[1]}), y1 = f32x2{bflo(zz.y), bfhi(zz.y)} * fsigmoid2(f32x2{v0[2], v0[3]} + f32x2{b0[2], b0[3]});
            const f32x2 y2 = f32x2{bflo(zz.z), bfhi(zz.z)} * fsigmoid2(f32x2{v1[0], v1[1]} + f32x2{b1[0], b1[1]}), y3 = f32x2{bflo(zz.w), bfhi(zz.w)} * fsigmoid2(f32x2{v1[2], v1[3]} + f32x2{b1[2], b1[3]});
            u32x4 o; o.x = pkbf(y0.x, y0.y); o.y = pkbf(y1.x, y1.y); o.z = pkbf(y2.x, y2.y); o.w = pkbf(y3.x, y3.y);
            *(u32x4*)(Y + (size_t)row * 512 + col) = o; })
    }
};

struct EpiChain {
    static constexpr bool PERM = true, FP8 = false;
    const bf16_t* SA; const bf16_t* SB; bf16_t* O;
    typedef Pre0 Pre; __device__ __forceinline__ Pre prefetch(const Unit&, int, int, int, int) const { return Pre(); }
    __device__ __forceinline__ void operator()(f32x4 (&acc)[2][2][4][2], const Unit& u, int wr, int wc, int fr, int fq, const Pre&) const {
        if (u.seg == 0) {
#pragma unroll
            for (int ai = 0; ai < 2; ++ai) {
#pragma unroll
                for (int m = 0; m < 4; ++m)
#pragma unroll
                    for (int bj = 0; bj < 2; ++bj) { const size_t off = (size_t)(u.pm * 256 + ai * 128 + wr * 64 + m * 16 + fr) * 1024 + u.pn * 256 + bj * 128 + wc * 32 + 8 * fq;
                        const u32x4 a = __builtin_nontemporal_load((const u32x4*)(SA + off)); const u32x4 b = *(const u32x4*)(SB + off);
                        f32x4& v0 = acc[ai][bj][m][0]; f32x4& v1 = acc[ai][bj][m][1];
                        v0[0] *= bflo(a.x) * __builtin_amdgcn_rcpf(fmaxf(bflo(b.x), 1e-30f)); v0[1] *= bfhi(a.x) * __builtin_amdgcn_rcpf(fmaxf(bfhi(b.x), 1e-30f)); v0[2] *= bflo(a.y) * __builtin_amdgcn_rcpf(fmaxf(bflo(b.y), 1e-30f)); v0[3] *= bfhi(a.y) * __builtin_amdgcn_rcpf(fmaxf(bfhi(b.y), 1e-30f));
                        v1[0] *= bflo(a.z) * __builtin_amdgcn_rcpf(fmaxf(bflo(b.z), 1e-30f)); v1[1] *= bfhi(a.z) * __builtin_amdgcn_rcpf(fmaxf(bfhi(b.z), 1e-30f)); v1[2] *= bflo(a.w) * __builtin_amdgcn_rcpf(fmaxf(bflo(b.w), 1e-30f)); v1[3] *= bfhi(a.w) * __builtin_amdgcn_rcpf(fmaxf(bfhi(b.w), 1e-30f)); }
                asm volatile("" ::: "memory"); }
        } else {
            EPI_ROWS({ const size_t off = (size_t)(u.pm * 256 + rloc) * 1024 + u.pn * 256 + cloc;
                const u32x4 s = __builtin_nontemporal_load((const u32x4*)(SB + off));
                u32x4 o; o.x = pkbf(v0[0] * bflo(s.x), v0[1] * bfhi(s.x)); o.y = pkbf(v0[2] * bflo(s.y), v0[3] * bfhi(s.y)); o.z = pkbf(v1[0] * bflo(s.z), v1[1] * bfhi(s.z)); o.w = pkbf(v1[2] * bflo(s.w), v1[3] * bfhi(s.w));
                *(u32x4*)(O + off) = o; })
        }
    }
};

struct EpiResid {
    static constexpr bool PERM = true, FP8 = false;
    const float* X; bf16_t* O; float* RSS;
    typedef Pre0 Pre; __device__ __forceinline__ Pre prefetch(const Unit&, int, int, int, int) const { return Pre(); }
    __device__ __forceinline__ void operator()(AccRef acc, const Unit& u, int wr, int wc, int fr, int fq, const Pre&) const {
#pragma unroll
        for (int ai = 0; ai < 2; ++ai)
#pragma unroll
            for (int m = 0; m < 4; ++m) { const int row = u.pm * 256 + ai * 128 + wr * 64 + m * 16 + fr; const size_t off = (size_t)row * 1024 + u.pn * 256 + wc * 32 + 8 * fq; float ss = 0.f;
#pragma unroll
                for (int bj = 0; bj < 2; ++bj) { const f32x4 o0 = __builtin_nontemporal_load((const f32x4*)(X + off + bj * 128)) + acc[ai][bj][m][0], o1 = __builtin_nontemporal_load((const f32x4*)(X + off + bj * 128 + 4)) + acc[ai][bj][m][1];
                    u32x4 o; o.x = pkbf(o0[0], o0[1]); o.y = pkbf(o0[2], o0[3]); o.z = pkbf(o1[0], o1[1]); o.w = pkbf(o1[2], o1[3]); *(u32x4*)(O + off + bj * 128) = o;
                    ss += ((o0[0] * o0[0] + o0[1] * o0[1]) + (o0[2] * o0[2] + o0[3] * o0[3])) + ((o1[0] * o1[0] + o1[1] * o1[1]) + (o1[2] * o1[2] + o1[3] * o1[3])); }
                ss += __shfl_xor(ss, 16); ss += __shfl_xor(ss, 32);
                if (fq == 0) RSS[(size_t)row * 16 + u.pn * 4 + wc] = ss;
                if (m == 3) asm volatile("" ::: "memory"); }
    }
};

struct EpiSwiglu {
    static constexpr bool PERM = true, FP8 = true;
    const float* b1; unsigned char* ACT;
    typedef Pre16 Pre;
    __device__ __forceinline__ Pre prefetch(const Unit& u, int wr, int wc, int fr, int fq) const { const float* bb = b1 + (size_t)u.aux * 2048 + 2 * (u.pn * 128 + wc * 32 + 8 * fq); Pre p;
        p.v[0] = *(const f32x4*)(bb); p.v[1] = *(const f32x4*)(bb + 4); p.v[2] = *(const f32x4*)(bb + 8); p.v[3] = *(const f32x4*)(bb + 12); return p; }
    __device__ __forceinline__ void operator()(AccRef acc, const Unit& u, int wr, int wc, int fr, int fq, const Pre& pre) const {
        const int j0 = u.pn * 128 + wc * 32 + 8 * fq;
        const f32x4 q0 = pre.v[0], q1 = pre.v[1], q2 = pre.v[2], q3 = pre.v[3];
        const f32x2 bg[4] = {{q0[0], q0[2]}, {q1[0], q1[2]}, {q2[0], q2[2]}, {q3[0], q3[2]}};
        const f32x2 bl[4] = {f32x2{q0[1], q0[3]} + 1.f, f32x2{q1[1], q1[3]} + 1.f, f32x2{q2[1], q2[3]} + 1.f, f32x2{q3[1], q3[3]} + 1.f};
#pragma unroll
        for (int ai = 0; ai < 2; ++ai)
#pragma unroll
            for (int m = 0; m < 4; ++m) { const int row = u.pm * 256 + ai * 128 + wr * 64 + m * 16 + fr;
                const f32x4 g0 = acc[ai][0][m][0], g1 = acc[ai][0][m][1], l0 = acc[ai][1][m][0], l1 = acc[ai][1][m][1];
                const f32x2 gg[4] = {{g0[0], g0[1]}, {g0[2], g0[3]}, {g1[0], g1[1]}, {g1[2], g1[3]}}, ll[4] = {{l0[0], l0[1]}, {l0[2], l0[3]}, {l1[0], l1[1]}, {l1[2], l1[3]}}; f32x2 r[4];
#pragma unroll
                for (int q = 0; q < 4; ++q) { f32x2 xg = gg[q] + bg[q], xl = ll[q] + bl[q];
                    xg.x = __builtin_amdgcn_fmed3f(xg.x, -40.f, 7.f); xg.y = __builtin_amdgcn_fmed3f(xg.y, -40.f, 7.f);
                    xl.x = __builtin_amdgcn_fmed3f(xl.x, -6.f, 8.f); xl.y = __builtin_amdgcn_fmed3f(xl.y, -6.f, 8.f);
                    const f32x2 t = xg * -2.4554669595930157f;
                    const f32x2 d = f32x2{__builtin_amdgcn_exp2f(t.x), __builtin_amdgcn_exp2f(t.y)} + 1.0f;
                    const float rp = __builtin_amdgcn_rcpf(d.x * d.y);
                    r[q] = (xg * (f32x2{d.y, d.x} * rp)) * xl; }
                u32x2 o; o.x = pkfp8x4(r[0].x, r[0].y, r[1].x, r[1].y); o.y = pkfp8x4(r[2].x, r[2].y, r[3].x, r[3].y);
                *(u32x2*)(ACT + (size_t)row * 1024 + j0) = o; }
    }
};
struct EpiExpOut {
    static constexpr bool PERM = true, FP8 = true; static constexpr int NST = 0;
    const float* b2; unsigned char* YK;
    typedef Pre16 Pre;
    __device__ __forceinline__ Pre prefetch(const Unit& u, int wr, int wc, int fr, int fq) const { const float* bb = b2 + (size_t)u.aux * 1024 + u.pn * 256 + 64 * wc + 16 * fq; Pre p;
        p.v[0] = *(const f32x4*)(bb); p.v[1] = *(const f32x4*)(bb + 4); p.v[2] = *(const f32x4*)(bb + 8); p.v[3] = *(const f32x4*)(bb + 12); return p; }
    __device__ __forceinline__ void operator()(AccRef acc, const Unit& u, int wr, int wc, int fr, int fq, const Pre& pre) const {
        const int lb = u.pn * 256 + 64 * wc + 16 * fq;
        const f32x4 b0 = pre.v[0], b1 = pre.v[1], b2v = pre.v[2], b3 = pre.v[3];
#pragma unroll
        for (int r = 0; r < 8; ++r) { const int ai = r >> 2, m = r & 3, row = u.pm * 256 + ai * 128 + wr * 64 + m * 16 + fr;
            const f32x4 a0 = acc[ai][0][m][0] + b0, a1 = acc[ai][0][m][1] + b1, a2 = acc[ai][1][m][0] + b2v, a3 = acc[ai][1][m][1] + b3;
            u32x4 o; o.x = pkfp8x4(a0[0], a0[1], a0[2], a0[3]); o.y = pkfp8x4(a1[0], a1[1], a1[2], a1[3]); o.z = pkfp8x4(a2[0], a2[1], a2[2], a2[3]); o.w = pkfp8x4(a3[0], a3[1], a3[2], a3[3]);
            *(u32x4*)(YK + (size_t)row * 1024 + lb) = o; }
    }
};

constexpr int RSTR = 272;
__device__ __forceinline__ bf16x8 lds_frag(const LAS unsigned char* base, int row0, int k0, int fr, int fq) { return *(const LAS bf16x8*)(base + (row0 + fr) * RSTR + (k0 + 8 * fq) * 2); }

typedef short s16x4 __attribute__((ext_vector_type(4)));
__device__ __forceinline__ bf16x8 tr_frag(const LAS unsigned char* p, int rowstride) {
    const s16x4 lo = __builtin_bit_cast(s16x4, __builtin_amdgcn_ds_read_tr16_b64_v4i16((LAS s16x4*)(p)));
    const s16x4 hi = __builtin_bit_cast(s16x4, __builtin_amdgcn_ds_read_tr16_b64_v4i16((LAS s16x4*)(p + 16 * rowstride)));
    return (bf16x8){lo[0], lo[1], lo[2], lo[3], hi[0], hi[1], hi[2], hi[3]};
}
constexpr int KSTR_A = 288, VSTR = 544;

__device__ __forceinline__ void ret_pass_a(Frame& F) {
    const int tid_o = otid(), lane_o = tid_o & 63;
    const int tid = tid_o, wid = F.wave, lane = lane_o, fr = lane & 15, fq = lane >> 4;
    const bf16_t* Kb = (const bf16_t*)(F.ws + WS_K); const bf16_t* V = (const bf16_t*)(F.ws + WS_V); bf16_t* KV = (bf16_t*)(F.ws + WS_KV);
    LAS unsigned char* sK = F.lds; LAS unsigned char* sV = F.lds + 128 * KSTR_A;
    const int trow = 4 * fq + (fr >> 2), tcol = 4 * (fr & 3);
    constexpr int NIT = 16 * (RNC - 1);
    int it = blockIdx.x; if (it >= NIT) return;
    u32x4 kr[4], vr[8];
#define RA_LOAD(item) do { const int bh_ = (item) / (RNC - 1), c_ = (item) % (RNC - 1), tok_ = (bh_ >> 2) * 8192 + c_ * 128, h_ = bh_ & 3; \
        _Pragma("unroll") for (int i = 0; i < 4; ++i) { const int id = tid + NTHREADS * i; kr[i] = *(const u32x4*)(Kb + ((size_t)(tok_ + (id >> 4))) * 512 + h_ * 128 + (id & 15) * 8); } \
        _Pragma("unroll") for (int i = 0; i < 8; ++i) { const int id = tid + NTHREADS * i; vr[i] = *(const u32x4*)(V + ((size_t)(tok_ + (id >> 5))) * 1024 + h_ * 256 + (id & 31) * 8); } } while (0)
    RA_LOAD(it);
    for (;;) {
        const int bh = it / (RNC - 1), c = it % (RNC - 1);
#pragma unroll
        for (int i = 0; i < 4; ++i) { const int id = tid + NTHREADS * i; *(LAS u32x4*)(sK + (id >> 4) * KSTR_A + (id & 15) * 16) = kr[i]; }
#pragma unroll
        for (int i = 0; i < 8; ++i) { const int id = tid + NTHREADS * i; *(LAS u32x4*)(sV + (id >> 5) * VSTR + (id & 31) * 16) = vr[i]; }
        LDS_BARRIER();
        const int nit = it + F.G; const bool has = nit < NIT;
        if (has) RA_LOAD(nit);
        f32x4 acc[2][8];
#pragma unroll
        for (int mt = 0; mt < 2; ++mt)
#pragma unroll
            for (int nt = 0; nt < 8; ++nt) acc[mt][nt] = (f32x4){0.f, 0.f, 0.f, 0.f};
#pragma unroll
        for (int ks = 0; ks < 4; ++ks) {
            bf16x8 vf[2];
#pragma unroll
            for (int mt = 0; mt < 2; ++mt) vf[mt] = tr_frag(sV + (ks * 32 + trow) * VSTR + (wid * 32 + mt * 16 + tcol) * 2, VSTR);
#pragma unroll
            for (int nt = 0; nt < 8; ++nt) { const bf16x8 kf = tr_frag(sK + (ks * 32 + trow) * KSTR_A + (nt * 16 + tcol) * 2, KSTR_A);
#pragma unroll
                for (int mt = 0; mt < 2; ++mt) acc[mt][nt] = __builtin_amdgcn_mfma_f32_16x16x32_bf16(kf, vf[mt], acc[mt][nt], 0, 0, 0); }
        }
        LDS_BARRIER();
        LAS unsigned char* stg = sV + wid * (32 * 272);
#pragma unroll
        for (int mt = 0; mt < 2; ++mt)
#pragma unroll
            for (int nt = 0; nt < 8; ++nt) { u32x2 w; w.x = pkbf(acc[mt][nt][0], acc[mt][nt][1]); w.y = pkbf(acc[mt][nt][2], acc[mt][nt][3]); *(LAS u32x2*)(stg + (mt * 16 + fr) * 272 + (nt * 16 + 4 * fq) * 2) = w; }
        LDS_WAIT(); asm volatile("" ::: "memory");
        { bf16_t* o = KV + ((size_t)(bh * RNC + c)) * 32768 + (size_t)(wid * 32) * 128; int tg = lane; asm volatile("" : "+v"(tg));
#pragma unroll
          for (int i2 = 0; i2 < 8; ++i2) { const int id = tg + 64 * i2; *(u32x4*)(o + (id >> 4) * 128 + (id & 15) * 8) = *(const LAS u32x4*)(stg + (id >> 4) * 272 + (id & 15) * 16); } }
        LDS_BARRIER();
        if (!has) break;
        it = nit;
    }
#undef RA_LOAD
}

__device__ __forceinline__ void ret_pass_b(Frame& F) {
    const int tid_o = otid();
    const bf16_t* KV = (const bf16_t*)(F.ws + WS_KV); bf16_t* ST = (bf16_t*)(F.ws + WS_ST);
    if (tid_o >= 256) return;
    const bool g256 = (F.G == 256); const int nmine = g256 ? (F.vcu < 128 ? 192 : 320) : 256, base = g256 ? (F.vcu < 128 ? F.vcu * 192 : 128 * 192 + (F.vcu - 128) * 320) : F.vcu * 256, step = g256 ? 65536 : F.G * 256;
    for (int j = tid_o; j < nmine; j += 256) for (int i = base + j; i < 16 * 4096; i += step) {
        const int bh = i >> 12, e8 = i & 4095, h = bh & 3; const float gC = __builtin_amdgcn_exp2f(128.0f * l2gamma(h));
        float s[8];
#pragma unroll
        for (int q = 0; q < 8; ++q) s[q] = 0.f;
        const bf16_t* kp = KV + (size_t)bh * RNC * 32768 + e8 * 8; bf16_t* sp = ST + (size_t)bh * RNC * 32768 + e8 * 8;
#pragma unroll 8
        for (int c = 0; c < RNC; ++c) {
            u32x4 o; o.x = pkbf(s[0], s[1]); o.y = pkbf(s[2], s[3]); o.z = pkbf(s[4], s[5]); o.w = pkbf(s[6], s[7]); *(u32x4*)(sp + (size_t)c * 32768) = o;
            if (c < RNC - 1) { const u32x4 kv = __builtin_nontemporal_load((const u32x4*)(kp + (size_t)c * 32768));
                s[0] = (s[0] + bflo(kv.x)) * gC; s[1] = (s[1] + bfhi(kv.x)) * gC; s[2] = (s[2] + bflo(kv.y)) * gC; s[3] = (s[3] + bfhi(kv.y)) * gC;
                s[4] = (s[4] + bflo(kv.z)) * gC; s[5] = (s[5] + bfhi(kv.z)) * gC; s[6] = (s[6] + bflo(kv.w)) * gC; s[7] = (s[7] + bfhi(kv.w)) * gC; }
        }
    }
}

__device__ __forceinline__ void ret_pass_c(Frame& F) {
    const int tid_o = otid(), lane_o = tid_o & 63;
    const int tid = tid_o, wid = F.wave, lane = lane_o, fr = lane & 15, fq = lane >> 4;
    const bf16_t* Q = (const bf16_t*)(F.ws + WS_Q); const bf16_t* Kb = (const bf16_t*)(F.ws + WS_K); const bf16_t* V = (const bf16_t*)(F.ws + WS_V);
    const bf16_t* ST = (const bf16_t*)(F.ws + WS_ST); const bf16_t* GS = (const bf16_t*)(F.ws + WS_GS); bf16_t* RETG = (bf16_t*)(F.ws + WS_RETG);
    const float* gng = inp(I_GNG);
    LAS unsigned char* sK = F.lds;
    LAS unsigned char* sV = F.lds + 128 * RSTR;
    const int trow = 4 * fq + (fr >> 2), tcol = 4 * (fr & 3);
    constexpr int NIT = 16 * RNC;
    int it = blockIdx.x; if (it >= NIT) return;
    u32x4 kr[4], vr[8]; bf16x8 qf[4], qn[4];
#define RC_LOAD(item, qdst) do { int tl = tid; asm volatile("" : "+v"(tl)); const int bh_ = (item) / RNC, c_ = (item) % RNC, tok_ = (bh_ >> 2) * 8192 + c_ * 128, h_ = bh_ & 3; \
        _Pragma("unroll") for (int i = 0; i < 4; ++i) { const int id = tl + NTHREADS * i; kr[i] = __builtin_nontemporal_load((const u32x4*)(Kb + ((size_t)(tok_ + (id >> 4))) * 512 + h_ * 128 + (id & 15) * 8)); } \
        _Pragma("unroll") for (int i = 0; i < 8; ++i) { const int id = tl + NTHREADS * i; vr[i] = __builtin_nontemporal_load((const u32x4*)(V + ((size_t)(tok_ + (id >> 5))) * 1024 + h_ * 256 + (id & 31) * 8)); } \
        _Pragma("unroll") for (int ks = 0; ks < 4; ++ks) qdst[ks] = __builtin_nontemporal_load((const bf16x8*)(Q + ((size_t)(tok_ + wid * 16 + fr)) * 512 + h_ * 128 + ks * 32 + fq * 8)); } while (0)
    RC_LOAD(it, qf);
    for (;;) {
        const int bh = it / RNC, c = it % RNC, b = bh >> 2, h = bh & 3; const int tok0 = b * 8192 + c * 128;
        int tw = tid; asm volatile("" : "+v"(tw));
#pragma unroll
        for (int i = 0; i < 4; ++i) { const int id = tw + NTHREADS * i; *(LAS u32x4*)(sK + (id >> 4) * RSTR + (id & 15) * 16) = kr[i]; }
#pragma unroll
        for (int i = 0; i < 8; ++i) { const int id = tw + NTHREADS * i; *(LAS u32x4*)(sV + (id >> 5) * VSTR + (id & 31) * 16) = vr[i]; }
        LDS_BARRIER();
        u32x4 sr[8]; int ts = tid; asm volatile("" : "+v"(ts));
#pragma unroll
        for (int i = 0; i < 8; ++i) { const int id = ts + NTHREADS * i; sr[i] = __builtin_nontemporal_load((const u32x4*)(ST + ((size_t)(bh * RNC + c)) * 32768 + (id >> 4) * 128 + (id & 15) * 8)); }
        f32x4 sc[8];
#pragma unroll
        for (int nt = 0; nt < 8; ++nt) { sc[nt] = (f32x4){0.f, 0.f, 0.f, 0.f};
            if (nt <= wid) {
#pragma unroll
                for (int ks = 0; ks < 4; ++ks) sc[nt] = __builtin_amdgcn_mfma_f32_16x16x32_bf16(lds_frag(sK, nt * 16, ks * 32, fr, fq), qf[ks], sc[nt], 0, 0, 0);
                if (nt == wid) {
#pragma unroll
                    for (int r = 0; r < 4; ++r) if (4 * fq + r > fr) sc[nt][r] = 0.f;
                } } }
        LDS_BARRIER();
        LAS unsigned char* sP = sK + wid * 16 * RSTR;
#pragma unroll
        for (int nt = 0; nt < 8; ++nt) { u32x2 o; o.x = pkbf(sc[nt][0], sc[nt][1]); o.y = pkbf(sc[nt][2], sc[nt][3]); *(LAS u32x2*)(sP + fr * RSTR + (nt * 16 + 4 * fq) * 2) = o; }
        LDS_WAIT(); asm volatile("" ::: "memory");
        bf16x8 pf[4];
#pragma unroll
        for (int ks = 0; ks < 4; ++ks) { const u32x2 p0 = *(const LAS u32x2*)(sP + fr * RSTR + (ks * 32 + 4 * fq) * 2), p1 = *(const LAS u32x2*)(sP + fr * RSTR + (ks * 32 + 16 + 4 * fq) * 2);
            u32x4 pp; pp.x = p0.x; pp.y = p0.y; pp.z = p1.x; pp.w = p1.y; pf[ks] = __builtin_bit_cast(bf16x8, pp); }
        f32x4 acc[16];
#pragma unroll
        for (int nt = 0; nt < 16; ++nt) acc[nt] = (f32x4){0.f, 0.f, 0.f, 0.f};
#pragma unroll
        for (int ks = 0; ks < 4; ++ks) if (2 * ks <= wid) {
#pragma unroll
            for (int nt = 0; nt < 16; ++nt) { acc[nt] = __builtin_amdgcn_mfma_f32_16x16x32_bf16(tr_frag(sV + (ks * 32 + trow) * VSTR + (nt * 16 + tcol) * 2, VSTR), pf[ks], acc[nt], 0, 0, 0); } }
        LDS_BARRIER();
#pragma unroll
        for (int i = 0; i < 8; ++i) { const int id = ts + NTHREADS * i; *(LAS u32x4*)(sV + (id >> 4) * RSTR + (id & 15) * 16) = sr[i]; }
        u32x4 gsr[8]; int tg = lane; asm volatile("" : "+v"(tg));
#pragma unroll
        for (int i2 = 0; i2 < 8; ++i2) { const int id = tg + 64 * i2; gsr[i2] = __builtin_nontemporal_load((const u32x4*)(GS + (size_t)(tok0 + wid * 16 + (id >> 5)) * 1024 + h * 256 + (id & 31) * 8)); }
        const int nit = it + F.G; const bool has = nit < NIT;
        if (has) RC_LOAD(nit, qn);
        LDS_BARRIER();
#pragma unroll
        for (int ks = 0; ks < 4; ++ks)
#pragma unroll
            for (int nt = 0; nt < 16; ++nt) { acc[nt] = __builtin_amdgcn_mfma_f32_16x16x32_bf16(lds_frag(sV, nt * 16, ks * 32, fr, fq), qf[ks], acc[nt], 0, 0, 0); }
        float s = 0.f;
#pragma unroll
        for (int nt = 0; nt < 16; ++nt) s += (acc[nt][0] + acc[nt][1]) + (acc[nt][2] + acc[nt][3]);
        s += __shfl_xor(s, 16); s += __shfl_xor(s, 32);
        const float mu = s * (1.f / 256.f); float q = 0.f;
#pragma unroll
        for (int nt = 0; nt < 16; ++nt) { const f32x4 d = acc[nt] - mu; q += (d[0] * d[0] + d[1] * d[1]) + (d[2] * d[2] + d[3] * d[3]); }
        q += __shfl_xor(q, 16); q += __shfl_xor(q, 32);
        const float rstd = 1.0f / sqrtf(q * (1.f / 256.f) + NORM_EPS);
        LDS_BARRIER();
        LAS unsigned char* stg = sV + wid * (16 * 528); int tg2 = lane; asm volatile("" : "+v"(tg2));
#pragma unroll
        for (int i2 = 0; i2 < 8; ++i2) { const int id = tg2 + 64 * i2; *(LAS u32x4*)(stg + (id >> 5) * 528 + (id & 31) * 16) = gsr[i2]; }
        LDS_WAIT(); asm volatile("" ::: "memory");
#pragma unroll
        for (int nt = 0; nt < 16; ++nt) { const int col = nt * 16 + 4 * fq; const f32x4 gg = *(const f32x4*)(gng + h * 256 + col); LAS u32x2* sp = (LAS u32x2*)(stg + fr * 528 + col * 2); const u32x2 gs = *sp;
            const f32x4 y = (acc[nt] - mu) * rstd * gg;
            u32x2 o; o.x = pkbf(y[0] * bflo(gs.x), y[1] * bfhi(gs.x)); o.y = pkbf(y[2] * bflo(gs.y), y[3] * bfhi(gs.y));
            *sp = o; }
        LDS_WAIT(); asm volatile("" ::: "memory"); int tg3 = lane; asm volatile("" : "+v"(tg3));
#pragma unroll
        for (int i2 = 0; i2 < 8; ++i2) { const int id = tg3 + 64 * i2; *(u32x4*)(RETG + (size_t)(tok0 + wid * 16 + (id >> 5)) * 1024 + h * 256 + (id & 31) * 8) = *(const LAS u32x4*)(stg + (id >> 5) * 528 + (id & 31) * 16); }
        LDS_BARRIER();
        if (!has) break;
        it = nit;
#pragma unroll
        for (int ks = 0; ks < 4; ++ks) qf[ks] = qn[ks];
    }
#undef RC_LOAD
}

__device__ __forceinline__ void s5_scan(Frame& F, int first, int stride) {
    const int lane_o = otid() & 63;
    const float* VB = (const float*)(F.ws + WS_VBUF); bf16_t* AS5 = (bf16_t*)(F.ws + WS_AS5); const float* DB = (const float*)(F.ws + WS_DBUF);
    LAS float* TOT = (LAS float*)F.lds;
    for (int it = first; it < NB * S5G; it += stride) {
        const int b = it & 3, g = it >> 2, n = lane_o, seg = F.wave; const float dr = DB[(g * 64 + n) * 2], di = DB[(g * 64 + n) * 2 + 1];
        const size_t row0 = (size_t)g * 1024 + b * 256 + seg * 32;
        float vr[32], vi[32];
#pragma unroll
        for (int j = 0; j < 32; ++j) { vr[j] = VB[(row0 + j) * 128 + n]; vi[j] = VB[(row0 + j) * 128 + 64 + n]; }
        float lr[32], li[32]; float sr = 0.f, si = 0.f;
#pragma unroll
        for (int j = 0; j < 32; ++j) { lr[j] = sr; li[j] = si; const float tr = dr * sr - di * si + vr[j]; si = dr * si + di * sr + vi[j]; sr = tr; }
        TOT[(seg * 64 + n) * 2] = sr; TOT[(seg * 64 + n) * 2 + 1] = si;
        float p32r = 1.f, p32i = 0.f;
#pragma unroll
        for (int j = 0; j < 32; ++j) { const float tr = p32r * dr - p32i * di; p32i = p32r * di + p32i * dr; p32r = tr; }
        __syncthreads();
        float cr = 0.f, ci = 0.f;
        for (int s2 = 0; s2 < seg; ++s2) { const float tr_ = TOT[(s2 * 64 + n) * 2], ti_ = TOT[(s2 * 64 + n) * 2 + 1]; const float tr = p32r * cr - p32i * ci + tr_; ci = p32r * ci + p32i * cr + ti_; cr = tr; }
        float pr = 1.f, pi = 0.f;
#pragma unroll
        for (int j = 0; j < 32; ++j) {
            const float xr = lr[j] + pr * cr - pi * ci, xi = li[j] + pr * ci + pi * cr;
            bf16_t* ap = AS5 + (row0 + j) * 640 + 512 + n; ap[0] = (bf16_t)(pkbf(xr, 0.f) & 0xffff); ap[64] = (bf16_t)(pkbf(xi, 0.f) & 0xffff);
            const float tr = pr * dr - pi * di; pi = pr * di + pi * dr; pr = tr;
        }
        __syncthreads();
    }
}

#define TOP4_INS(val, idx) do { const float v_ = (val); const int i_ = (idx); const bool c0 = v_ > b0, c1 = v_ > b1, c2 = v_ > b2, c3 = v_ > b3; \
    b3 = c2 ? b2 : (c3 ? v_ : b3); i3 = c2 ? i2 : (c3 ? i_ : i3); b2 = c1 ? b1 : (c2 ? v_ : b2); i2 = c1 ? i1 : (c2 ? i_ : i2); \
    b1 = c0 ? b0 : (c1 ? v_ : b1); i1 = c0 ? i0 : (c1 ? i_ : i1); b0 = c0 ? v_ : b0; i0 = c0 ? i_ : i0; } while (0)
__device__ __forceinline__ void p8_router(Frame& F) {
    const int tid_o = otid(), lane_o = tid_o & 63;
    const int tid = tid_o, lane = lane_o, wid = F.wave, fr = lane & 15, fq = lane >> 4;
    LAS unsigned char* Wh = F.lds; LAS unsigned char* Wl = F.lds + 65536;
    LAS unsigned* lcnt = (LAS unsigned*)(F.lds + LDS_P8); LAS unsigned* lbase = lcnt + 32; LAS int* ent = (LAS int*)(F.lds + LDS_P8 + 256);
    const float* rw = inp(I_RW); const bf16_t* x1 = (const bf16_t*)(F.ws + WS_X1); unsigned char* H2 = (unsigned char*)(F.ws + WS_H2); const float* gg = inp(I_NFG); const float* rb = inp(I_RB);
    const float* rss = (const float*)(F.ws + WS_ROWSS);
    LAS float* gl = (LAS float*)ent;
    int* etok = (int*)(F.ws + WS_ETOK); int* inv = (int*)(F.ws + WS_INV); float* gate4 = (float*)(F.ws + WS_GATE4);
    for (int chn = blockIdx.x; chn < T / 128; chn += F.G) {
        const int tok = chn * 128 + wid * 16 + fr;
        const bf16_t* xrow = x1 + (size_t)tok * DM + fq * 8; unsigned char* hrow = H2 + (size_t)tok * DM + fq * 8; const LAS float* grow = gl + fq * 8;
        u32x4 xq[8];
#pragma unroll
        for (int i = 0; i < 8; ++i) xq[i] = __builtin_nontemporal_load((const u32x4*)(xrow + i * 32));
        { f32x4 wv[16];
#pragma unroll
          for (int it = 0; it < 16; ++it) wv[it] = *(const f32x4*)(rw + 4 * (tid + NTHREADS * it));
#pragma unroll
          for (int it = 0; it < 16; ++it) { const int i = 4 * (tid + NTHREADS * it), k = i >> 5, e0 = i & 31;
#pragma unroll
            for (int j = 0; j < 4; ++j) { const int e = e0 + j; const float w = wv[it][j];
                const unsigned hb = pkbf(w, 0.f) & 0xffffu; const float wl = w - __uint_as_float(hb << 16); const unsigned lb = pkbf(wl, 0.f) & 0xffffu;
                const int off = e * 2048 + ((((k >> 3) ^ (e & 15))) << 4) + (k & 7) * 2;
                *(LAS bf16_t*)(Wh + off) = (bf16_t)hb; *(LAS bf16_t*)(Wl + off) = (bf16_t)lb; } } }
        if (tid < 32) lcnt[tid] = 0u;
        if (tid < 256) *(LAS f32x4*)(gl + 4 * tid) = *(const f32x4*)(gg + 4 * tid);
        __syncthreads();
        float rs; { const f32x4* p = (const f32x4*)(rss + (size_t)tok * 16); const f32x4 a = p[0], b = p[1], c = p[2], d = p[3];
            const float ss = (((a[0] + a[1]) + (a[2] + a[3])) + ((b[0] + b[1]) + (b[2] + b[3]))) + (((c[0] + c[1]) + (c[2] + c[3])) + ((d[0] + d[1]) + (d[2] + d[3])));
            rs = 1.0f / sqrtf(ss * (1.f / DM) + NORM_EPS); }
        f32x4 acc[2]; acc[0] = (f32x4){0.f, 0.f, 0.f, 0.f}; acc[1] = acc[0];
#pragma nounroll
        for (int kb = 0; kb < 4; ++kb) {
        u32x4 xc[8];
#pragma unroll
        for (int i = 0; i < 8; ++i) xc[i] = xq[i];
        if (kb < 3) {
#pragma unroll
            for (int i = 0; i < 8; ++i) xq[i] = __builtin_nontemporal_load((const u32x4*)(xrow + (kb * 8 + 8 + i) * 32));
        }
#pragma unroll
        for (int ki = 0; ki < 8; ++ki) { const int ks = kb * 8 + ki;
            const u32x4 xp = xc[ki]; const f32x4 xa = (f32x4){bflo(xp.x), bfhi(xp.x), bflo(xp.y), bfhi(xp.y)}, xb = (f32x4){bflo(xp.z), bfhi(xp.z), bflo(xp.w), bfhi(xp.w)};
            const f32x4 ga = *(const LAS f32x4*)(grow + ks * 32), gb = *(const LAS f32x4*)(grow + ks * 32 + 4);
            const f32x4 ha = xa * rs * ga, hb = xb * rs * gb;
            u32x4 hp; hp.x = pkbf(ha[0], ha[1]); hp.y = pkbf(ha[2], ha[3]); hp.z = pkbf(hb[0], hb[1]); hp.w = pkbf(hb[2], hb[3]);
            { u32x2 h8; h8.x = pkfp8x4(ha[0], ha[1], ha[2], ha[3]); h8.y = pkfp8x4(hb[0], hb[1], hb[2], hb[3]); *(u32x2*)(hrow + ks * 32) = h8; }
            u32x4 lp; lp.x = pkbf(ha[0] - bflo(hp.x), ha[1] - bfhi(hp.x)); lp.y = pkbf(ha[2] - bflo(hp.y), ha[3] - bfhi(hp.y)); lp.z = pkbf(hb[0] - bflo(hp.z), hb[1] - bfhi(hp.z)); lp.w = pkbf(hb[2] - bflo(hp.w), hb[3] - bfhi(hp.w));
            const bf16x8 hv = __builtin_bit_cast(bf16x8, hp), lv = __builtin_bit_cast(bf16x8, lp);
#pragma unroll
            for (int et = 0; et < 2; ++et) { const int e = et * 16 + fr, off = e * 2048 + (((ks * 4 + fq) ^ (e & 15)) << 4);
                const bf16x8 wh = *(const LAS bf16x8*)(Wh + off), wl = *(const LAS bf16x8*)(Wl + off);
                acc[et] = __builtin_amdgcn_mfma_f32_16x16x32_bf16(wh, hv, acc[et], 0, 0, 0);
                acc[et] = __builtin_amdgcn_mfma_f32_16x16x32_bf16(wl, hv, acc[et], 0, 0, 0);
                acc[et] = __builtin_amdgcn_mfma_f32_16x16x32_bf16(wh, lv, acc[et], 0, 0, 0); }
        }
        }
        __syncthreads();
        LAS float* lgt = (LAS float*)F.lds + wid * 512;
#pragma unroll
        for (int et = 0; et < 2; ++et) { const f32x4 bb = *(const f32x4*)(rb + et * 16 + 4 * fq); *(LAS f32x4*)(lgt + fr * 32 + et * 16 + 4 * fq) = acc[et] + bb; }
        LDS_WAIT(); asm volatile("" ::: "memory");
        if (lane < 16) {
            float b0 = -__builtin_inff(), b1 = b0, b2 = b0, b3 = b0; int i0 = 0, i1 = 0, i2 = 0, i3 = 0;
#pragma unroll
            for (int q = 0; q < 8; ++q) { const f32x4 v4 = *(const LAS f32x4*)(lgt + lane * 32 + q * 4); TOP4_INS(v4[0], q * 4); TOP4_INS(v4[1], q * 4 + 1); TOP4_INS(v4[2], q * 4 + 2); TOP4_INS(v4[3], q * 4 + 3); }
            const float e1 = __expf(b1 - b0), e2 = __expf(b2 - b0), e3 = __expf(b3 - b0), inv = 1.0f / (1.0f + e1 + e2 + e3);
            const int t2 = chn * 128 + wid * 16 + lane; LAS int* en = ent + ((wid * 16 + lane) * 4) * 4;
            { const unsigned lp = atomicAdd((unsigned*)&lcnt[i0], 1u); en[0] = i0; en[1] = t2 * 4 + 0; en[2] = __float_as_int(inv); en[3] = (int)lp; }
            { const unsigned lp = atomicAdd((unsigned*)&lcnt[i1], 1u); en[4] = i1; en[5] = t2 * 4 + 1; en[6] = __float_as_int(e1 * inv); en[7] = (int)lp; }
            { const unsigned lp = atomicAdd((unsigned*)&lcnt[i2], 1u); en[8] = i2; en[9] = t2 * 4 + 2; en[10] = __float_as_int(e2 * inv); en[11] = (int)lp; }
            { const unsigned lp = atomicAdd((unsigned*)&lcnt[i3], 1u); en[12] = i3; en[13] = t2 * 4 + 3; en[14] = __float_as_int(e3 * inv); en[15] = (int)lp; }
        }
        __syncthreads();
        if (tid < 32) { lbase[tid] = atomicAdd(F.ctl + CW_ECNT + 64 * tid, lcnt[tid]); }
        __syncthreads();
        { const LAS int* en = ent + tid * 4; const int e = en[0]; const unsigned pos = lbase[e] + (unsigned)en[3];
          etok[(size_t)e * T + pos] = en[1]; inv[en[1]] = e * 32768 + (int)pos; gate4[en[1]] = __int_as_float(en[2]); }
        __syncthreads();
    }
}

__device__ __forceinline__ int build_tiles(Frame& F) {
    const int tid_o = otid();
    LAS int* pst = (LAS int*)(F.lds + LDS_PST); LAS int* cl = (LAS int*)(F.lds + LDS_CNT); LAS unsigned char* tile_e = F.lds + LDS_TILEE;
    __syncthreads();
    if (tid_o < 32) cl[tid_o] = (int)__hip_atomic_load(F.ctl + CW_ECNT + 64 * tid_o, __ATOMIC_RELAXED, __HIP_MEMORY_SCOPE_AGENT);
    __syncthreads();
    if (tid_o == 0) { int a = 0; for (int e = 0; e < 32; ++e) { pst[e] = a; a += (cl[e] + 255) & ~255; } pst[32] = a; }
    __syncthreads();
    const int ntiles = pst[32] >> 8;
    for (int t = tid_o; t < ntiles; t += NTHREADS) { int lo = 0;
        for (int st = 16; st >= 1; st >>= 1) if (t * 256 >= pst[lo + st]) lo += st;
        tile_e[t] = (unsigned char)lo; }
    __syncthreads();
    return ntiles;
}

__device__ __forceinline__ void p12_final(Frame& F, bool have_tables) {
    if (!have_tables) build_tiles(F);
    const int lane_o = otid() & 63; const LAS int* pst = (const LAS int*)(F.lds + LDS_PST);
    const int gw = F.vcu * NWAVES + F.wave, NGW = F.G * NWAVES; const unsigned char* YK = (const unsigned char*)(F.ws + WS_YK); const float* gg = inp(I_NFIN);
    const u32x4* inv = (const u32x4*)(F.ws + WS_INV); const f32x4* gate4 = (const f32x4*)(F.ws + WS_GATE4);
    f32x4 gv[4];
#pragma unroll
    for (int j = 0; j < 4; ++j) gv[j] = *((const f32x4*)gg + lane_o + 64 * j);
    u32x4 iv = inv[gw < T ? gw : 0]; f32x4 gt = gate4[gw < T ? gw : 0];
    for (int tok = gw; tok < T; tok += NGW) {
        const int r0 = pst[iv.x >> 15] + (int)(iv.x & 32767u), r1 = pst[iv.y >> 15] + (int)(iv.y & 32767u), r2 = pst[iv.z >> 15] + (int)(iv.z & 32767u), r3 = pst[iv.w >> 15] + (int)(iv.w & 32767u);
        const int* yr[4] = { (const int*)(YK + (size_t)r0 * DM) + lane_o, (const int*)(YK + (size_t)r1 * DM) + lane_o, (const int*)(YK + (size_t)r2 * DM) + lane_o, (const int*)(YK + (size_t)r3 * DM) + lane_o };
        const float gk[4] = { gt[0], gt[1], gt[2], gt[3] };
        const int nx = tok + NGW < T ? tok + NGW : tok; iv = inv[nx]; gt = gate4[nx];
        f32x4* xr = (f32x4*)(F.out + (size_t)tok * DM) + lane_o; const u32x2* x1r = (const u32x2*)((const bf16_t*)(F.ws + WS_X1) + (size_t)tok * DM) + lane_o; f32x4 v[4]; float s = 0.f;
#pragma unroll
        for (int j = 0; j < 4; ++j) { const u32x2 xp = __builtin_nontemporal_load(x1r + 64 * j); v[j] = (f32x4){bflo(xp.x), bfhi(xp.x), bflo(xp.y), bfhi(xp.y)};
#pragma unroll
            for (int k = 0; k < 4; ++k) { const int y = __builtin_nontemporal_load(yr[k] + 64 * j); const f32x2 lo = __builtin_amdgcn_cvt_pk_f32_fp8(y, false), hi = __builtin_amdgcn_cvt_pk_f32_fp8(y, true);
                v[j].x += gk[k] * lo[0]; v[j].y += gk[k] * lo[1]; v[j].z += gk[k] * hi[0]; v[j].w += gk[k] * hi[1]; }
            s += (v[j].x * v[j].x + v[j].y * v[j].y) + (v[j].z * v[j].z + v[j].w * v[j].w); }
        const float rs = 1.0f / sqrtf(wave_sum(s) * (1.f / DM) + NORM_EPS);
#pragma unroll
        for (int j = 0; j < 4; ++j) __builtin_nontemporal_store(v[j] * rs * gv[j], xr + 64 * j);
    }
}

constexpr int N_PHASES = 12;
struct Args { const float* in[26]; float* out; unsigned char* ws; int ph_lo, ph_hi, li, pad; };
__global__ void __launch_bounds__(NTHREADS, 2) fwd_kernel(Args args) {
    extern __shared__ __attribute__((aligned(16))) unsigned char lds[];
    Frame F;
    F.lds = (LAS unsigned char*)lds;
    const int tid_o = threadIdx.x; F.wave = __builtin_amdgcn_readfirstlane(tid_o >> 6);
    F.G = gridDim.x; { const int bx = blockIdx.x; F.vcu = (F.G % 8 == 0) ? (bx % 8) * (F.G / 8) + bx / 8 : bx; }
    F.ws = args.ws; F.ctl = (unsigned*)(args.ws + WS_CTL); F.out = args.out;
    for (int u = tid_o; u < (LDS_BYTES - LDSCTL_OFF) / 4; u += NTHREADS) ((LAS unsigned*)(F.lds + LDSCTL_OFF))[u] = 0u;
    __syncthreads();
    XcdBarrier bar; bar.bar = F.ctl + CW_BAR + args.li * XCD_BAR_WORDS; bar.x = 0; bar.st = nullptr;
    if (args.ph_hi - args.ph_lo > 1) bar = xcd_barrier_post(F.ctl + CW_BAR + args.li * XCD_BAR_WORDS, (volatile LAS unsigned*)(F.lds + LDSCTL_OFF) + 8);
    const int lo = args.ph_lo, hi = args.ph_hi;
#ifndef PHMASK
#define PHMASK 0xfff
#endif
#define IN(k) (((PHMASK >> (k)) & 1) && lo <= (k) && (k) < hi)
#define SEAM(k) do { if (IN(k) && IN((k) + 1)) xcd_barrier(bar); } while (0)
    LAS unsigned char* tile_e = F.lds + LDS_TILEE;

    if (IN(0)) { p0_prologue(F); SEAM(0); }
    if (IN(1)) {
        { pg8::Gemm g{(const void*)(F.ws + WS_H), (const void*)(F.ws + WS_WIN), 2048, 2048, 2048}; pg8::StaticOrder S; S.init(T / 256, IN_BF_TILES, F.G, (int)blockIdx.x);
          EpiInProj<false> E{F.ws};
          pg8::gemm_phase<EpiInProj<false>, pg8::StaticOrder, true>(F.lds, g, S, E); }
        { pg8::Gemm g{(const void*)(F.ws + WS_H8), (const void*)(F.ws + WS_WIN8), 1024, 1024, 1024}; pg8::StaticOrder S; S.init(T / 256, 22 - IN_BF_TILES, F.G, (int)blockIdx.x);
          EpiInProj<true> E{F.ws};
          pg8::gemm_phase<EpiInProj<true>, pg8::StaticOrder, true>(F.lds, g, S, E); }
        SEAM(1);
    }
    if (IN(2)) {
        ret_pass_a(F);
        pg8::Gemm g{(const bf16_t*)(F.ws + WS_AS5), (const bf16_t*)(F.ws + WS_BTV), S5K * 2, 1024, 1024}; pg8::GroupOrder S; S.init(S5G, 4, 1, 1024, 256, F.G, (int)blockIdx.x);
        EpiS5V E{(float*)(F.ws + WS_VBUF)};
        pg8::gemm_phase<EpiS5V, pg8::GroupOrder, true>(F.lds, g, S, E);
        SEAM(2);
    }
    if (IN(3)) { ret_pass_b(F); s5_scan(F, F.vcu, F.G); SEAM(3); }
    if (IN(4)) {
        ret_pass_c(F);
        pg8::Gemm g{(const bf16_t*)(F.ws + WS_AS5), (const bf16_t*)(F.ws + WS_BTY), S5K * 2, S5K * 2, S5K * 2}; pg8::GroupOrder S; S.init(S5G, 4, 2, 1024, 512, F.G, (int)blockIdx.x);
        EpiS5Y E{(const bf16_t*)(F.ws + WS_AS5), (bf16_t*)(F.ws + WS_Z), inp(I_D)};
        pg8::gemm_phase<EpiS5Y, pg8::GroupOrder, true>(F.lds, g, S, E);
        SEAM(4);
    }
    if (IN(5)) {
        pg8::Gemm g{(const bf16_t*)(F.ws + WS_Z), (const bf16_t*)(F.ws + WS_WGLU), 1024, 1024, 1024}; pg8::StaticOrder S; S.init(T / 256, 2, F.G, (int)blockIdx.x);
        EpiGlu E{(const bf16_t*)(F.ws + WS_Z), (bf16_t*)(F.ws + WS_YS5), inp(I_BGLU)};
        pg8::gemm_phase<EpiGlu, pg8::StaticOrder, true>(F.lds, g, S, E);
        SEAM(5);
    }
    if (IN(6)) {
        pg8::ChainOrder S; S.so.init(T / 256, 4, F.G, (int)blockIdx.x);
        pg8::Gemm g{(const bf16_t*)(F.ws + WS_YS5), (const bf16_t*)(F.ws + WS_WCAT), 1024, 3072, 1024, (const bf16_t*)(F.ws + WS_RETG), 2048, 2048};
        EpiChain E{(const bf16_t*)(F.ws + WS_SA), (const bf16_t*)(F.ws + WS_SB), (bf16_t*)(F.ws + WS_MERGED)};
        pg8::gemm_phase<EpiChain, pg8::ChainOrder, true>(F.lds, g, S, E);
        SEAM(6);
    }
    if (IN(7)) {
        pg8::Gemm g{(const bf16_t*)(F.ws + WS_MERGED), (const bf16_t*)(F.ws + WS_WOUT), 2048, 2048, 2048}; pg8::StaticOrder S; S.init(T / 256, 4, F.G, (int)blockIdx.x);
        EpiResid E{inp(I_X), (bf16_t*)(F.ws + WS_X1), (float*)(F.ws + WS_ROWSS)};
        pg8::gemm_phase<EpiResid, pg8::StaticOrder, true>(F.lds, g, S, E);
        SEAM(7);
    }
    if (IN(8)) { p8_router(F); SEAM(8); }
    if (IN(9)) {
        const int ntiles = build_tiles(F);
        pg8::Gemm g{(const void*)(F.ws + WS_H2), (const void*)(F.ws + WS_W1), 1024, 1024, 1024};
        pg8::ExpertOrder<true> S; S.so.init(ntiles, 8, F.G, (int)blockIdx.x); S.tile_e = tile_e; S.nfull = 2048; S.pst = (const LAS int*)(F.lds + LDS_PST); S.cl = (const LAS int*)(F.lds + LDS_CNT); S.etok = (const int*)(F.ws + WS_ETOK); S.egate = nullptr;
        EpiSwiglu E{inp(I_B1), (unsigned char*)(F.ws + WS_ACT)};
        pg8::gemm_phase<EpiSwiglu, pg8::ExpertOrder<true>, true>(F.lds, g, S, E);
        SEAM(9);
    }
    if (IN(10)) {
        const int ntiles = IN(9) ? (((const LAS int*)(F.lds + LDS_PST))[32] >> 8) : build_tiles(F);
        pg8::Gemm g{(const void*)(F.ws + WS_ACT), (const void*)(F.ws + WS_W2), 1024, 1024, 1024};
        pg8::ExpertOrder<false> S; S.so.init(ntiles, 4, F.G, (int)blockIdx.x); S.tile_e = tile_e; S.nfull = 1024; S.pst = (const LAS int*)(F.lds + LDS_PST); S.cl = (const LAS int*)(F.lds + LDS_CNT); S.etok = (const int*)(F.ws + WS_ETOK); S.egate = nullptr;
#if defined(PROBE_FASTA)
        if (args.li == 1) S.amask = 0;
#endif
        EpiExpOut E{inp(I_B2), (unsigned char*)(F.ws + WS_YK)};
        pg8::gemm_phase<EpiExpOut, pg8::ExpertOrder<false>, true>(F.lds, g, S, E);
        SEAM(10);
    }
    if (IN(11)) { p12_final(F, IN(9)); }
#undef IN
#undef SEAM
}

extern "C" void kernel_launch(void* const* d_in, const int* in_sizes, int n_in, void* d_out, int out_size, void* d_ws, size_t ws_size, hipStream_t stream) {
    static int grid = 0;
    if (grid == 0) {
        if (n_in != 26 || in_sizes[0] != T * DM || out_size != T * DM || ws_size < WS_END) { fprintf(stderr, "kernel_launch: unexpected shapes (n_in %d, in0 %d, out %d, ws %zu); nothing launched\n", n_in, n_in > 0 ? in_sizes[0] : -1, out_size, ws_size); grid = -1; return; }
        int dev = 0, cus = 0, per_cu = 0;
        if (hipGetDevice(&dev) != hipSuccess || hipDeviceGetAttribute(&cus, hipDeviceAttributeMultiprocessorCount, dev) != hipSuccess) { grid = -1; return; }
        if (hipFuncSetAttribute((const void*)fwd_kernel, hipFuncAttributeMaxDynamicSharedMemorySize, LDS_BYTES) != hipSuccess) { fprintf(stderr, "kernel_launch: hipFuncSetAttribute failed\n"); grid = -1; return; }
        if (hipOccupancyMaxActiveBlocksPerMultiprocessor(&per_cu, (const void*)fwd_kernel, NTHREADS, LDS_BYTES) != hipSuccess || per_cu < 1) { fprintf(stderr, "kernel_launch: the occupancy query admits %d workgroups of this kernel per CU; nothing launched\n", per_cu); grid = -1; return; }
        (void)hipGetLastError();
        grid = cus;
    }
    if (grid < 0) return;
    (void)hipMemsetAsync((char*)d_ws + WS_CTL, 0, CTL_ZERO_BYTES, stream);
    Args a{};
    for (int i = 0; i < 26; ++i) a.in[i] = (const float*)d_in[i];
    a.out = (float*)d_out; a.ws = (unsigned char*)d_ws;
#if defined(PROBE_FASTA)
    a.ph_lo = 0; a.ph_hi = 10; a.li = 0; hipLaunchKernelGGL(fwd_kernel, dim3(grid), dim3(NTHREADS), LDS_BYTES, stream, a);
    a.ph_lo = 10; a.ph_hi = 11; a.li = 1; hipLaunchKernelGGL(fwd_kernel, dim3(grid), dim3(NTHREADS), LDS_BYTES, stream, a);
    a.ph_lo = 10; a.ph_hi = N_PHASES; a.li = 2; hipLaunchKernelGGL(fwd_kernel, dim3(grid), dim3(NTHREADS), LDS_BYTES, stream, a);
#elif defined(PROBE_PHASE)
    { const int k = PROBE_PHASE;
      a.ph_lo = 0; a.ph_hi = k + 1; a.li = 0; hipLaunchKernelGGL(fwd_kernel, dim3(grid), dim3(NTHREADS), LDS_BYTES, stream, a);
      if (k == 8) (void)hipMemsetAsync((char*)d_ws + WS_CTL + CW_ECNT * 4, 0, 32 * 256, stream);
      a.ph_lo = k; a.ph_hi = k + 1; a.li = 1; hipLaunchKernelGGL(fwd_kernel, dim3(grid), dim3(NTHREADS), LDS_BYTES, stream, a);
      if (k + 1 < N_PHASES) { a.ph_lo = k + 1; a.ph_hi = N_PHASES; a.li = 2; hipLaunchKernelGGL(fwd_kernel, dim3(grid), dim3(NTHREADS), LDS_BYTES, stream, a); } }
#else
    if (MK_N_LAUNCHES == 1) {
        a.ph_lo = 0; a.ph_hi = N_PHASES; a.li = 0;
        hipLaunchKernelGGL(fwd_kernel, dim3(grid), dim3(NTHREADS), LDS_BYTES, stream, a);
    } else {
        for (int p = 0; p < N_PHASES; ++p) { a.ph_lo = p; a.ph_hi = p + 1; a.li = 0; hipLaunchKernelGGL(fwd_kernel, dim3(grid), dim3(NTHREADS), LDS_BYTES, stream, a); }
    }
#endif
}
```

```cpp
#include <hip/hip_runtime.h>
#include <cstdio>
#include <cstdint>

#define LAS __attribute__((address_space(3)))
#define GAS __attribute__((address_space(1)))
typedef unsigned short bf16_t;
typedef short bf16x8 __attribute__((ext_vector_type(8)));
typedef float f32x4 __attribute__((ext_vector_type(4)));
typedef float f32x2 __attribute__((ext_vector_type(2)));
typedef unsigned u32x4 __attribute__((ext_vector_type(4)));
typedef unsigned u32x2 __attribute__((ext_vector_type(2)));
typedef int i32x4 __attribute__((ext_vector_type(4)));
typedef int i32x8 __attribute__((ext_vector_type(8)));

#ifndef MK_N_LAUNCHES
#define MK_N_LAUNCHES 1
#endif

constexpr int NB = 4, SEQ = 8192, T = NB * SEQ, DM = 1024, INW = 5632;
constexpr int S5W = 512, S5G = 32, S5N = 64, S5Q = 32, S5NCH = SEQ / S5Q, S5ROWS = NB * S5NCH, S5K = 640;
constexpr int RH = 4, RDK = 128, RDV = 256, RC = 128, RNC = SEQ / RC;
constexpr int NE = 32, DFF = 1024, MAXTILES = 544, MAXROWS = MAXTILES * 256;
constexpr float NORM_EPS = 1e-5f;

__device__ __forceinline__ unsigned pkbf(float lo, float hi) { typedef __bf16 bf2 __attribute__((ext_vector_type(2))); f32x2 v = {lo, hi}; bf2 b = __builtin_convertvector(v, bf2); return __builtin_bit_cast(unsigned, b); }
__device__ __forceinline__ unsigned pkfp8x4(float a, float b, float c, float d) { int p = 0; p = __builtin_amdgcn_cvt_pk_fp8_f32(a, b, p, false); p = __builtin_amdgcn_cvt_pk_fp8_f32(c, d, p, true); return (unsigned)p; }
__device__ __forceinline__ float bflo(unsigned u) { return __uint_as_float(u << 16); }
__device__ __forceinline__ float bfhi(unsigned u) { return __uint_as_float(u & 0xffff0000u); }
__device__ __forceinline__ float fsigmoid(float x) { return __builtin_amdgcn_rcpf(1.0f + __builtin_amdgcn_exp2f(-1.4426950408889634f * x)); }
typedef float f32x2 __attribute__((ext_vector_type(2)));
__device__ __forceinline__ f32x2 fsigmoid2(f32x2 x) { const f32x2 t = x * -1.4426950408889634f; const f32x2 d = f32x2{__builtin_amdgcn_exp2f(t.x), __builtin_amdgcn_exp2f(t.y)} + 1.0f; return f32x2{__builtin_amdgcn_rcpf(d.x), __builtin_amdgcn_rcpf(d.y)}; }
__device__ __forceinline__ float wave_sum(float v) {
#pragma unroll
    for (int o = 1; o < 64; o <<= 1) v += __shfl_xor(v, o);
    return v;
}
#define LDS_WAIT() asm volatile("s_waitcnt lgkmcnt(0)" ::: "memory")
#define VM_WAIT() asm volatile("s_waitcnt vmcnt(0)" ::: "memory")
#define LDS_BARRIER() do { asm volatile("s_waitcnt lgkmcnt(0)" ::: "memory"); __builtin_amdgcn_s_barrier(); asm volatile("" ::: "memory"); } while (0)

namespace pg8 {
constexpr int BM = 256, BK = 64, HALF = 128, HTB = HALF * BK * 2, STAGE_BYTES = 8 * HTB, NXCD = 8, WGM = 8;
constexpr int TOKBUF_OFF = 131072 + 13312;
constexpr int ROWBUF_OFF = 131072 + 1024;
__host__ __device__ __forceinline__ int lds_byte(int r, int c) { const int st = (r >> 4) * 2 + (c >> 5), rr = r & 15, cc = c & 31, ob = rr * 64 + cc * 2; return st * 1024 + (ob ^ (((ob >> 9) & 1) << 5)); }
__host__ __device__ __forceinline__ void stage_rc(int b, int& R, int& C) { const int st = b / 1024, sb = b % 1024, swz = sb ^ (((sb >> 9) & 1) << 5); R = (st >> 1) * 16 + swz / 64; C = (st & 1) * 32 + (swz % 64) / 2; }
__host__ __device__ __forceinline__ int perm32(int rho) { const int n = rho >> 4, i = rho & 15; return 8 * (i >> 2) + 4 * n + (i & 3); }

struct Unit { int pm, pn, arow, brow, aux, slot, seg; };
struct Gemm { const void* A; const void* Bt; int lda, ldb, K; const void* A2 = nullptr; int lda2 = 0, K2 = 0; };

struct StaticOrder {
    static constexpr bool GATHER = false, ROWINFO = false, CHAIN = false;
    int nM, nN, nwg, G, c; bool rev = false;
    __device__ void init(int nM_, int nN_, int G_, int c_) { nM = nM_; nN = nN_; nwg = nM * nN; G = G_; c = c_; }
    __device__ __forceinline__ bool tile(int i, int& pm, int& pn) const {
        const long L = (long)i * G + c; if (L >= nwg) return false;
        int wgid = (int)L; { const int q = nwg / NXCD, r = nwg % NXCD, xcd = wgid % NXCD; int off = wgid / NXCD; if (rev) off = q + (xcd < r ? 1 : 0) - 1 - off;
            wgid = (xcd < r ? xcd * (q + 1) : r * (q + 1) + (xcd - r) * q) + off; }
        const int nig = WGM * nN, gid = wgid / nig, fm = gid * WGM, gsz = (nM - fm) < WGM ? (nM - fm) : WGM;
        pm = fm + ((wgid % nig) % gsz); pn = (wgid % nig) / gsz; return true;
    }
    __device__ __forceinline__ bool next(int i, Unit& u) const { if (!tile(i, u.pm, u.pn)) return false; u.arow = u.pm * BM; u.brow = u.pn * BM; u.aux = 0; return true; }
};
struct GroupOrder {
    static constexpr bool GATHER = false, ROWINFO = false, CHAIN = false;
    int nMg, nNg, per, nwg, G, c, arows, brows;
    __device__ void init(int ng, int nMg_, int nNg_, int arows_, int brows_, int G_, int c_) { nMg = nMg_; nNg = nNg_; per = nMg * nNg; nwg = ng * per; G = G_; c = c_; arows = arows_; brows = brows_; }
    __device__ __forceinline__ bool next(int i, Unit& u) const {
        const long L = (long)i * G + c; if (L >= nwg) return false;
        const int g = (int)L / per, r = (int)L % per; u.pm = r % nMg; u.pn = r / nMg; u.arow = g * arows + u.pm * BM; u.brow = g * brows + u.pn * BM; u.aux = g; return true;
    }
};
struct ChainOrder {
    static constexpr bool GATHER = false, ROWINFO = false, CHAIN = true;
    StaticOrder so;
    __device__ __forceinline__ bool next(int i, Unit& u) const { if (!so.tile(i >> 1, u.pm, u.pn)) return false; u.arow = u.pm * BM; u.brow = u.pn * BM; u.aux = 0; u.seg = i & 1; return true; }
};
template <bool GATHER_> struct ExpertOrder {
    static constexpr bool GATHER = GATHER_, ROWINFO = false, CHAIN = false;
    const float* egate; int amask = -1;
    StaticOrder so; const LAS unsigned char* tile_e; int nfull; const LAS int* pst; const LAS int* cl; const int* etok;
    __device__ __forceinline__ bool next(int i, Unit& u) const {
        if (!so.tile(i, u.pm, u.pn)) return false;
        const int e = (int)tile_e[u.pm]; u.arow = GATHER_ ? 0 : (u.pm * BM) & amask; u.brow = e * nfull + u.pn * BM; u.aux = e; return true;
    }
    __device__ __forceinline__ const int* tok_src(const Unit& u, int rho) const { const int e = u.aux, i = u.pm * BM + rho - pst[e]; return etok + (size_t)e * 32768 + (i < cl[e] ? i : 0); }
    __device__ __forceinline__ const float* gate_src(const Unit& u, int rho) const { const int e = u.aux, i = u.pm * BM + rho - pst[e]; return egate + (size_t)e * 32768 + (i < cl[e] ? i : 0); }
};

template <class Epi, class Sched, bool ALIGN_EPI>
__device__ __forceinline__ void gemm_phase(LAS unsigned char* lds, const Gemm g, const Sched& S, const Epi& E) {
    int tid_ = threadIdx.x; asm volatile("" : "+v"(tid_));
    const int tid = tid_, wid = __builtin_amdgcn_readfirstlane(tid >> 6), lane = tid & 63, wr = wid >> 2, wc = wid & 3, fr = lane & 15, fq = lane >> 4;
    const int nt0 = g.K / (BK * 2);
    unsigned voffA[2], voffB[2]; int stR[2], stC[2];
#pragma unroll
    for (int i = 0; i < 2; ++i) { int R, C; stage_rc(tid * 16 + i * 8192, R, C); const int Rb = Epi::PERM ? ((R & ~31) + perm32(R & 31)) : R; stR[i] = R; stC[i] = C;
        voffA[i] = (unsigned)(R * g.lda + C * 2); voffB[i] = (unsigned)(Rb * g.ldb + C * 2); }
    unsigned gv[2][2];
#pragma unroll
    for (int h = 0; h < 2; ++h)
#pragma unroll
        for (int i = 0; i < 2; ++i) gv[h][i] = voffA[i] + (unsigned)(h * HALF * g.lda);
    LAS int* tokbuf = (LAS int*)(lds + TOKBUF_OFF);
    const size_t kstep = (size_t)(BK * 2);
    const size_t hstepB = (size_t)HALF * g.ldb;
    const unsigned ldsw = (unsigned)wid * 1024u;
    const unsigned ldsbase = (unsigned)(size_t)lds + ldsw;
    const int aoff = lds_byte(wr * 64 + fr, fq * 8), boff = lds_byte(wc * 32 + fr, fq * 8);
#define PG8_SA(b, h) (((b) * 2 + (h)) * HTB)
#define PG8_SB(b, h) ((4 + (b) * 2 + (h)) * HTB)
#define PG8_STAGE(bufoff, gbase, voff) do { _Pragma("unroll") for (int _i = 0; _i < 2; ++_i) \
        asm volatile("s_mov_b32 m0, %2\n\ts_nop 0\n\tglobal_load_lds_dwordx4 %0, %1" :: "v"((voff)[_i]), "s"((const char*)(gbase)), "s"(ldsbase + (unsigned)((bufoff) + _i * 8192)) : "memory", "m0"); } while (0)
#define PG8_STAGE_A(bufoff, kptr, h) PG8_STAGE(bufoff, kptr, gv[h])
#define PG8_LD8(p) __builtin_shufflevector(*(const LAS i32x4*)(p), *(const LAS i32x4*)((p) + 1024), 0, 1, 2, 3, 4, 5, 6, 7)
#define PG8_LDA(dst, b, h) do { _Pragma("unroll") for (int m = 0; m < 4; ++m) dst[m] = PG8_LD8(lds + PG8_SA(b, h) + aoff + m * 2048); } while (0)
#define PG8_LDB(dst, b, h) do { _Pragma("unroll") for (int n = 0; n < 2; ++n) dst[n] = PG8_LD8(lds + PG8_SB(b, h) + boff + n * 2048); } while (0)
#define PG8_HALF(x, k) __builtin_bit_cast(bf16x8, __builtin_shufflevector(x, x, 4 * (k), 4 * (k) + 1, 4 * (k) + 2, 4 * (k) + 3))
#define PG8_MMA(ai, bj, At, Bt) do { __builtin_amdgcn_s_setprio(1); _Pragma("unroll") for (int m = 0; m < 4; ++m) _Pragma("unroll") for (int n = 0; n < 2; ++n) { \
        if constexpr (Epi::FP8) {   \
            acc[ai][bj][m][n] = __builtin_amdgcn_mfma_scale_f32_16x16x128_f8f6f4(Bt[n], At[m], acc[ai][bj][m][n], 0, 0, 0, 0x7a7a7a7a, 0, 0x7f7f7f7f); \
        } else { acc[ai][bj][m][n] = __builtin_amdgcn_mfma_f32_16x16x32_bf16(PG8_HALF(Bt[n], 0), PG8_HALF(At[m], 0), acc[ai][bj][m][n], 0, 0, 0); \
                 acc[ai][bj][m][n] = __builtin_amdgcn_mfma_f32_16x16x32_bf16(PG8_HALF(Bt[n], 1), PG8_HALF(At[m], 1), acc[ai][bj][m][n], 0, 0, 0); } } \
        __builtin_amdgcn_s_setprio(0); } while (0)
#define PG8_WAIT_V(n) asm volatile("s_waitcnt vmcnt(" #n ")" ::: "memory")
#define PG8_WAIT_L(n) asm volatile("s_waitcnt lgkmcnt(" #n ")" ::: "memory")
#define PG8_BAR __builtin_amdgcn_s_barrier()
#define PG8_SCHED __builtin_amdgcn_sched_barrier(0)
    Unit cur, nxt; int ui = 0;
    if (!S.next(0, cur)) return;
    typename Epi::Pre pre = E.prefetch(cur, wr, wc, fr, fq);
    f32x4 acc[2][2][4][2];
#pragma unroll
    for (int a = 0; a < 2; ++a)
#pragma unroll
        for (int b = 0; b < 2; ++b)
#pragma unroll
            for (int m = 0; m < 4; ++m)
#pragma unroll
                for (int n = 0; n < 2; ++n) { typedef unsigned long long u64x2 __attribute__((ext_vector_type(2))); u64x2 z;
                    asm volatile("v_mov_b64 %0, 0" : "=v"(z.x)); asm volatile("v_mov_b64 %0, 0" : "=v"(z.y)); acc[a][b][m][n] = __builtin_bit_cast(f32x4, z); }
    i32x8 At[4], B0[2], B1[2];
    const char* cA = (const char*)g.A + (size_t)cur.arow * g.lda; const char* cB = (const char*)g.Bt + (size_t)cur.brow * g.ldb;
    if constexpr (Sched::GATHER) {
#pragma unroll
        for (int h = 0; h < 2; ++h)
#pragma unroll
            for (int i = 0; i < 2; ++i) { const int tokk = *S.tok_src(cur, HALF * h + stR[i]); gv[h][i] = (unsigned)(tokk >> 2) * (unsigned)g.lda + (unsigned)stC[i] * 2u; }
    }
    if constexpr (Sched::ROWINFO) {
        LAS int* rb = (LAS int*)(lds + ROWBUF_OFF); if (tid < 256) rb[tid] = *S.tok_src(cur, tid); else rb[tid] = __float_as_int(*S.gate_src(cur, tid - 256));
    }
    PG8_STAGE(PG8_SB(0, 0), cB, voffB); PG8_STAGE(PG8_SB(0, 1), cB + hstepB, voffB); PG8_STAGE_A(PG8_SA(0, 0), cA, 0); PG8_STAGE_A(PG8_SA(0, 1), cA, 1);
    if (wr == 1) PG8_BAR;
    PG8_WAIT_V(2); PG8_BAR;
    PG8_STAGE(PG8_SB(1, 0), cB + kstep, voffB); PG8_STAGE_A(PG8_SA(1, 0), cA + kstep, 0); PG8_STAGE(PG8_SB(1, 1), cB + hstepB + kstep, voffB);
    PG8_WAIT_V(6); PG8_BAR;
    for (;;) {
        const bool has_next = S.next(ui + 1, nxt);
        const char* nA = has_next ? (const char*)g.A + (size_t)nxt.arow * g.lda : cA; const char* nB = has_next ? (const char*)g.Bt + (size_t)nxt.brow * g.ldb : cB;
        int nt = nt0;
        if constexpr (Sched::CHAIN) { if (has_next && nxt.seg) { nA = (const char*)g.A2 + (size_t)nxt.arow * g.lda2; nB += g.K; } if (cur.seg) nt = g.K2 / (BK * 2); }
        if constexpr (Sched::GATHER) {
            if (has_next && wid < 4) __builtin_amdgcn_global_load_lds((const unsigned*)S.tok_src(nxt, 64 * wid + lane), (LAS unsigned*)(tokbuf + ((ui + 1) & 1) * 256 + 64 * wid), 4, 0, 0);
        }
        if constexpr (Sched::ROWINFO) {
            if (has_next) { LAS unsigned* dst = (LAS unsigned*)(lds + ROWBUF_OFF) + ((ui + 1) % 3) * 512 + 64 * wid;
                const unsigned* src = wid < 4 ? (const unsigned*)S.tok_src(nxt, 64 * wid + lane) : (const unsigned*)S.gate_src(nxt, 64 * (wid - 4) + lane);
                __builtin_amdgcn_global_load_lds(src, dst, 4, 0, 0); }
        }
#pragma nounroll
        for (int t = 0; t < nt; t += 2) {
            const bool last = (t == nt - 2);
            const char* a1 = cA + (size_t)(t + 1) * kstep;
            const char* a2 = last ? nA : cA + (size_t)(t + 2) * kstep; const char* b2 = last ? nB : cB + (size_t)(t + 2) * kstep;
            const char* a3 = a2 + kstep; const char* b3 = b2 + kstep;
            PG8_LDB(B0, 0, 0); PG8_LDB(B1, 0, 1); PG8_SCHED; PG8_LDA(At, 0, 0); PG8_STAGE_A(PG8_SA(1, 1), a1, 1);
            if constexpr (!Sched::GATHER && !Sched::CHAIN) { if (last && has_next) { asm volatile("" : "+v"(gv[0][0]), "+v"(gv[0][1]), "+v"(gv[1][0]), "+v"(gv[1][1])); } }
            if constexpr (Sched::CHAIN) {
                if (last && has_next) { const int ldn = nxt.seg ? g.lda2 : g.lda;
#pragma unroll
                    for (int h = 0; h < 2; ++h)
#pragma unroll
                        for (int i = 0; i < 2; ++i) gv[h][i] = (unsigned)((HALF * h + stR[i]) * ldn + stC[i] * 2); }
            }
            if constexpr (Sched::GATHER) {
                if (last && has_next) {
#pragma unroll
                    for (int h = 0; h < 2; ++h)
#pragma unroll
                        for (int i = 0; i < 2; ++i) { const int tokk = tokbuf[((ui + 1) & 1) * 256 + HALF * h + stR[i]]; gv[h][i] = (unsigned)(tokk >> 2) * (unsigned)g.lda + (unsigned)stC[i] * 2u; }
                }
            }
            PG8_WAIT_V(8); PG8_WAIT_L(0); PG8_BAR; PG8_MMA(0, 0, At, B0); PG8_MMA(0, 1, At, B1); PG8_BAR; PG8_SCHED;
            PG8_STAGE(PG8_SB(0, 0), b2, voffB); PG8_STAGE(PG8_SB(0, 1), b2 + hstepB, voffB); PG8_STAGE_A(PG8_SA(0, 0), a2, 0); PG8_LDA(At, 0, 1);
            PG8_WAIT_V(8); PG8_WAIT_L(0); PG8_BAR; PG8_MMA(1, 0, At, B0); PG8_MMA(1, 1, At, B1); PG8_BAR; PG8_SCHED;
            PG8_LDB(B0, 1, 0); PG8_LDB(B1, 1, 1); PG8_SCHED; PG8_LDA(At, 1, 0); PG8_STAGE_A(PG8_SA(0, 1), a2, 1);
            PG8_WAIT_V(8); PG8_WAIT_L(0); PG8_BAR; PG8_MMA(0, 0, At, B0); PG8_MMA(0, 1, At, B1); PG8_BAR; PG8_SCHED;
            PG8_STAGE(PG8_SB(1, 0), b3, voffB); PG8_STAGE(PG8_SB(1, 1), b3 + hstepB, voffB); PG8_STAGE_A(PG8_SA(1, 0), a3, 0); PG8_LDA(At, 1, 1);
            PG8_WAIT_V(8); PG8_WAIT_L(0); PG8_BAR; PG8_MMA(1, 0, At, B0); PG8_MMA(1, 1, At, B1); PG8_BAR; PG8_SCHED;
        }
        if constexpr (ALIGN_EPI) { if (wr == 0) PG8_BAR; }
        { int fr_e = fr, fq_e = fq; asm volatile("" : "+v"(fr_e), "+v"(fq_e));
          cur.slot = ui % 3; E(acc, cur, wr, wc, fr_e, fq_e, pre); }
        if (!has_next) break;
        if (!(Sched::CHAIN && cur.seg == 0)) {
#pragma unroll
        for (int a = 0; a < 2; ++a)
#pragma unroll
            for (int b = 0; b < 2; ++b)
#pragma unroll
                for (int m = 0; m < 4; ++m)
#pragma unroll
                    for (int n = 0; n < 2; ++n) { typedef unsigned long long u64x2 __attribute__((ext_vector_type(2))); u64x2 z;
                    asm volatile("v_mov_b64 %0, 0" : "=v"(z.x)); asm volatile("v_mov_b64 %0, 0" : "=v"(z.y)); acc[a][b][m][n] = __builtin_bit_cast(f32x4, z); }
        }
        cur = nxt; cA = nA; cB = nB; ++ui;
        pre = E.prefetch(cur, wr, wc, fr, fq);
        if constexpr (ALIGN_EPI) { if (wr == 1) PG8_BAR; }
    }
    PG8_WAIT_V(0);
    if constexpr (!ALIGN_EPI) { if (wr == 0) PG8_BAR; }
    PG8_BAR;
#undef PG8_SA
#undef PG8_SB
#undef PG8_STAGE
#undef PG8_STAGE_A
#undef PG8_LDA
#undef PG8_LDB
#undef PG8_MMA
#undef PG8_LD8
#undef PG8_HALF
#undef PG8_WAIT_V
#undef PG8_WAIT_L
#undef PG8_BAR
#undef PG8_SCHED
}
}
using pg8::Unit;

constexpr size_t MiB = 1u << 20;
constexpr size_t WS_CTL = 0, CTL_ZERO_BYTES = 64 * 1024;
constexpr int IN_BF_TILES = 6;
constexpr size_t WS_WIN = 2 * MiB;
constexpr size_t WS_WIN8 = 6 * MiB;
constexpr size_t WS_WGLU = 13 * MiB;
constexpr size_t WS_WCAT = 14 * MiB;
constexpr size_t WS_WOUT = 17 * MiB;
constexpr size_t WS_ROPE = 19 * MiB;
constexpr size_t WS_BTY = 35 * MiB;
constexpr size_t WS_BTV = 55 * MiB;
constexpr size_t WS_DBUF = 63 * MiB;
constexpr size_t WS_W1 = 64 * MiB;
constexpr size_t WS_W2 = 192 * MiB;
constexpr size_t WS_H = 256 * MiB;
constexpr size_t WS_Z = 256 * MiB, WS_YS5 = 288 * MiB;
constexpr size_t WS_AS5 = 320 * MiB;
constexpr size_t WS_VBUF = 360 * MiB;
constexpr size_t WS_Q = 376 * MiB, WS_K = 408 * MiB, WS_V = 440 * MiB;
constexpr size_t WS_GS = 536 * MiB, WS_SA = 600 * MiB, WS_SB = 664 * MiB;
constexpr size_t WS_KV = 728 * MiB;
constexpr size_t WS_ST = 856 * MiB;
constexpr size_t WS_RETG = 920 * MiB;
constexpr size_t WS_H8 = 984 * MiB;
constexpr size_t WS_MERGED = 440 * MiB;
constexpr size_t WS_H2 = 256 * MiB;
constexpr size_t WS_XS = 320 * MiB;
constexpr size_t WS_YK = 320 * MiB;
constexpr size_t WS_ACT = 592 * MiB;
constexpr size_t WS_ETOK = 864 * MiB, WS_INV = 872 * MiB, WS_GATE4 = 873 * MiB;
constexpr size_t WS_X1 = 728 * MiB;
constexpr size_t WS_ROWSS = 876 * MiB;
constexpr size_t WS_END = 1024 * MiB;
static_assert(WS_RETG + 64 * MiB <= WS_END && WS_ACT + (size_t)MAXROWS * 2048 <= WS_ETOK && WS_XS + (size_t)MAXROWS * 2048 <= WS_ACT, "d_ws map");
constexpr int CW_ECNT = 64;
constexpr int CW_QUEUE = 2112;
constexpr int CW_BAR = 4096;

constexpr int RING_BYTES = 131072;
constexpr int LDSCTL_OFF = RING_BYTES;
constexpr int LDS_TILEE = LDSCTL_OFF + 256;
constexpr int LDS_P8 = LDSCTL_OFF + 1024;
constexpr int LDS_PST = LDSCTL_OFF + 12288, LDS_CNT = LDSCTL_OFF + 12288 + 256;
constexpr int LDS_BYTES = 147456;

#define XB_TMO      128
#define XB_XCNT(j)  (256  + 64 * (j))
#define XB_XSUB(j)  (1280 + 64 * (j))
#define XB_XGEN(j)  (2304 + 64 * (j))
#define XB_TOP      3328
#define XB_TOPGEN   3392
#define XCD_BAR_WORDS 3456
#define XB_SPIN_CAP (1u << 18)
__device__ __forceinline__ unsigned xb_ld(unsigned* p)              { return __hip_atomic_load(p, __ATOMIC_RELAXED, __HIP_MEMORY_SCOPE_AGENT); }
__device__ __forceinline__ unsigned xb_add(unsigned* p, unsigned v) { return __hip_atomic_fetch_add(p, v, __ATOMIC_RELAXED, __HIP_MEMORY_SCOPE_AGENT); }
__device__ __forceinline__ unsigned xb_xcc_id() { return (unsigned)__builtin_amdgcn_s_getreg((3 << 11) | 20) & 0xFu; }
#define XB_SPIN(cond, bar) do { unsigned _sp = 0; while (cond) { __builtin_amdgcn_s_sleep(1); \
    if ((++_sp & 255u) == 0u) { if (xb_ld(&(bar)[XB_TMO])) break; if (_sp > XB_SPIN_CAP) { atomicAdd(&(bar)[XB_TMO], 1u); break; } } } } while (0)
struct XcdBarrier { unsigned* bar; unsigned x; volatile LAS unsigned* st; };
__device__ __forceinline__ XcdBarrier xcd_barrier_post(unsigned* bar, volatile LAS unsigned* st) {
    XcdBarrier b; b.bar = bar; b.x = xb_xcc_id(); b.st = st;
    if (threadIdx.x == 0) (void)xb_add(&bar[XB_XCNT(b.x)], 1u);
    return b;
}
__device__ __forceinline__ void xcd_barrier_complete(unsigned* bar, unsigned x, unsigned& nloc, unsigned& nx) {
    const unsigned G = gridDim.x * gridDim.y * gridDim.z;
    unsigned sum, cnt, mine, sp = 0u;
    for (;;) {
        sum = 0u; cnt = 0u; mine = 0u;
#pragma unroll
        for (unsigned j = 0; j < 16; ++j) { const unsigned c = xb_ld(&bar[XB_XCNT(j)]); sum += c; cnt += (c > 0u) ? 1u : 0u; mine = (j == x) ? c : mine; }
        if (sum == G) break;
        __builtin_amdgcn_s_sleep(1);
        if ((++sp & 255u) == 0u) { if (xb_ld(&bar[XB_TMO])) break; if (sp > XB_SPIN_CAP) { atomicAdd(&bar[XB_TMO], 1u); break; } }
    }
    nloc = mine > 0u ? mine : 1u; nx = cnt > 0u ? cnt : 1u;
}
__device__ __forceinline__ void xcd_barrier(const XcdBarrier& b) {
    asm volatile("s_waitcnt vmcnt(0)" ::: "memory");
    __syncthreads();
    if (threadIdx.x == 0) {
        unsigned* bar = b.bar;
        __builtin_amdgcn_s_waitcnt(0);
        unsigned nloc = b.st[0], nx = b.st[1];
        if (nloc == 0u) { xcd_barrier_complete(bar, b.x, nloc, nx); b.st[0] = nloc; b.st[1] = nx; }
        const unsigned old = xb_add(&bar[XB_XSUB(b.x)], 1u);
        const unsigned gen = old / nloc;
        if (old + 1u == (gen + 1u) * nloc) {
            __builtin_amdgcn_fence(__ATOMIC_RELEASE, "agent");
            asm volatile("s_waitcnt vmcnt(0)" ::: "memory");
            const unsigned og = xb_add(&bar[XB_TOP], 1u);
            const unsigned tg = og / nx;
            if (og + 1u == (tg + 1u) * nx) xb_add(&bar[XB_TOPGEN], 1u);
            else XB_SPIN(xb_ld(&bar[XB_TOPGEN]) == tg, bar);
            __builtin_amdgcn_fence(__ATOMIC_ACQUIRE, "agent");
            xb_add(&bar[XB_XGEN(b.x)], 1u);
            asm volatile("s_waitcnt vmcnt(0)" ::: "memory");
        } else {
            XB_SPIN(xb_ld(&bar[XB_XGEN(b.x)]) == gen, bar);
            __builtin_amdgcn_fence(__ATOMIC_ACQUIRE, "agent");
            asm volatile("s_waitcnt vmcnt(0)" ::: "memory");
        }
    }
    __syncthreads();
}

constexpr int NWAVES = 8, NTHREADS = NWAVES * 64;
struct Frame {
    LAS unsigned char* lds;
    unsigned* ctl;
    int wave, vcu, G;
    unsigned char* ws;
    float* out;
};
enum { I_X = 0, I_POS, I_NMG, I_WIN, I_LRE, I_LIM, I_LDT, I_BRE, I_BIM, I_CRE, I_CIM, I_D, I_WGLU, I_BGLU, I_GNG, I_WBS5, I_WBRET, I_WOUT, I_NFG, I_RW, I_RB, I_W1, I_B1, I_W2, I_B2, I_NFIN };

__device__ __forceinline__ const float* inp(int i) {
    typedef const float* const __attribute__((address_space(4))) * kptr_t;
    kptr_t p = (kptr_t)__builtin_amdgcn_kernarg_segment_ptr(); asm volatile("" : "+s"(p)); return p[i];
}

__device__ __forceinline__ int otid() { int t = threadIdx.x; asm volatile("" : "+v"(t)); return t; }

__device__ __forceinline__ void sincos_d(double x, double& s, double& c) {
    const double n = __builtin_rint(x * 0.63661977236758134308);
    double r = __builtin_fma(-n, 1.57079632679489655800e+00, x);
    r = __builtin_fma(-n, 6.12323399573676603587e-17, r);
    const double r2 = r * r;
    double ps = -1.0 / 1307674368000.0;
    ps = __builtin_fma(ps, r2, 1.0 / 6227020800.0); ps = __builtin_fma(ps, r2, -1.0 / 39916800.0); ps = __builtin_fma(ps, r2, 1.0 / 362880.0);
    ps = __builtin_fma(ps, r2, -1.0 / 5040.0); ps = __builtin_fma(ps, r2, 1.0 / 120.0); ps = __builtin_fma(ps, r2, -1.0 / 6.0);
    const double sr = __builtin_fma(ps * r2, r, r);
    double pc = 1.0 / 20922789888000.0;
    pc = __builtin_fma(pc, r2, -1.0 / 87178291200.0); pc = __builtin_fma(pc, r2, 1.0 / 479001600.0); pc = __builtin_fma(pc, r2, -1.0 / 3628800.0);
    pc = __builtin_fma(pc, r2, 1.0 / 40320.0); pc = __builtin_fma(pc, r2, -1.0 / 720.0); pc = __builtin_fma(pc, r2, 1.0 / 24.0); pc = __builtin_fma(pc, r2, -0.5);
    const double cr = __builtin_fma(pc, r2, 1.0);
    const int q = ((int)n) & 3;
    s = (q == 0) ? sr : (q == 1) ? cr : (q == 2) ? -sr : -cr;
    c = (q == 0) ? cr : (q == 1) ? -sr : (q == 2) ? -cr : sr;
}
__device__ __forceinline__ double exp_d(double x) {
    const double k = __builtin_rint(x * 1.44269504088896338700);
    double r = __builtin_fma(-k, 6.93147180369123816490e-01, x);
    r = __builtin_fma(-k, 1.90821492927058770002e-10, r);
    double p = 1.0 / 6227020800.0;
    p = __builtin_fma(p, r, 1.0 / 479001600.0); p = __builtin_fma(p, r, 1.0 / 39916800.0); p = __builtin_fma(p, r, 1.0 / 3628800.0); p = __builtin_fma(p, r, 1.0 / 362880.0);
    p = __builtin_fma(p, r, 1.0 / 40320.0); p = __builtin_fma(p, r, 1.0 / 5040.0); p = __builtin_fma(p, r, 1.0 / 720.0); p = __builtin_fma(p, r, 1.0 / 120.0);
    p = __builtin_fma(p, r, 1.0 / 24.0); p = __builtin_fma(p, r, 1.0 / 6.0); p = __builtin_fma(p, r, 0.5); p = __builtin_fma(p, r, 1.0); p = __builtin_fma(p, r, 1.0);
    const long long bits = ((long long)((int)k + 1023)) << 52;
    return p * __builtin_bit_cast(double, bits);
}

__device__ __forceinline__ void p0_load_item(const float* W, int N, int k0, int n0, LAS float* scr, int lane) {
    const int kq = lane >> 3, n4 = (lane & 7) * 4; f32x4 v[8];
#pragma unroll
    for (int i = 0; i < 8; ++i) v[i] = __builtin_nontemporal_load((const f32x4*)(W + (size_t)(k0 + 8 * i + kq) * N + n0 + n4));
#pragma unroll
    for (int i = 0; i < 8; ++i) { LAS float* d = scr + (8 * i + kq) * 33 + n4; d[0] = v[i].x; d[1] = v[i].y; d[2] = v[i].z; d[3] = v[i].w; }
    LDS_WAIT(); asm volatile("" ::: "memory");
}
template <bool QKPERM>
__device__ __forceinline__ void p0_transpose_item(const float* W, int K, int N, bf16_t* WT, LAS float* scr, int item, int lane, int ldw) {
    const int nblk = N / 32, kb = item / nblk, nb = item % nblk, k0 = 64 * kb, n0 = 32 * nb;
    p0_load_item(W, N, k0, n0, scr, lane);
    const int c = lane & 7;
#pragma unroll
    for (int j = 0; j < 4; ++j) { const int n = (lane >> 3) + 8 * j; const LAS float* s = scr + (8 * c) * 33 + n;
        u32x4 o; o.x = pkbf(s[0 * 33], s[1 * 33]); o.y = pkbf(s[2 * 33], s[3 * 33]); o.z = pkbf(s[4 * 33], s[5 * 33]); o.w = pkbf(s[6 * 33], s[7 * 33]);
        int nd = n0 + n;
        if (QKPERM) { if (nd >= 512 && nd < 1536) { const int d = nd & 127; const int p = (d < 64) ? (8 * (d >> 2) + (d & 3)) : (8 * ((d - 64) >> 2) + 4 + (d & 3)); nd = (nd & ~127) + p; } }
        *(u32x4*)(WT + (size_t)nd * ldw + k0 + 8 * c) = o; }
    LDS_WAIT(); asm volatile("" ::: "memory");
}

template <int MODE>
__device__ __forceinline__ void p0_transpose_item_fp8(const float* W, int K, int N, unsigned char* WT, LAS float* scr, int item, int lane) {
    const int nblk = N / 32, kb = item / nblk, nb = item % nblk, k0 = 64 * kb, n0 = 32 * nb;
    p0_load_item(W, N, k0, n0, scr, lane);
    const int c = lane & 7;
#pragma unroll
    for (int j = 0; j < 4; ++j) { const int n = (lane >> 3) + 8 * j; const LAS float* s = scr + (8 * c) * 33 + n;
        u32x2 o; o.x = pkfp8x4(32.f * s[0 * 33], 32.f * s[1 * 33], 32.f * s[2 * 33], 32.f * s[3 * 33]); o.y = pkfp8x4(32.f * s[4 * 33], 32.f * s[5 * 33], 32.f * s[6 * 33], 32.f * s[7 * 33]);
        int nd = n0 + n; if (MODE == 1) { const int jj = nd >> 1; nd = 256 * (jj >> 7) + 128 * (nd & 1) + (jj & 127); }
        if (MODE == 2) nd -= 256 * IN_BF_TILES;
        if (MODE == 3) { const int L = nd & 255; nd = (nd & ~255) + 128 * ((L >> 3) & 1) + 32 * (L >> 6) + 8 * ((L >> 4) & 3) + (L & 7); }
        __builtin_nontemporal_store(o, (u32x2*)(WT + (size_t)nd * K + k0 + 8 * c)); }
    LDS_WAIT(); asm volatile("" ::: "memory");
}

__device__ __forceinline__ void p0_s5_group(Frame& F, int g, int part) {
    const int tid_o = otid();
    LAS float* PW = (LAS float*)(F.lds);
    LAS float* BP = (LAS float*)(F.lds + 17408);
    LAS float* CC = (LAS float*)(F.lds + 25600);
    LAS float* KD = (LAS float*)(F.lds + 33792);
    LAS float* FF = (LAS float*)(F.lds + 66560);
    const int tid = tid_o;
    if (tid < 64) {
        const int n = tid;
        const double lr = (double)inp(I_LRE)[g * 64 + n], li = (double)inp(I_LIM)[g * 64 + n], dt = exp_d((double)inp(I_LDT)[g]);
        const double mag = exp_d(lr * dt); double sn, cs; sincos_d(li * dt, sn, cs);
        const double ar = mag * cs, aim = mag * sn;
        const double nr = ar - 1.0, ni = aim, den = lr * lr + li * li;
        FF[2 * n] = (float)((nr * lr + ni * li) / den); FF[2 * n + 1] = (float)((ni * lr - nr * li) / den);
        double pr = 1.0, pi = 0.0;
        for (int d = 0; d <= 32; ++d) { PW[(d * 64 + n) * 2] = (float)pr; PW[(d * 64 + n) * 2 + 1] = (float)pi; const double t = pr * ar - pi * aim; pi = pr * aim + pi * ar; pr = t; }
        if (part == 0) { float* db = (float*)(F.ws + WS_DBUF) + (g * 64 + n) * 2; db[0] = PW[(32 * 64 + n) * 2]; db[1] = PW[(32 * 64 + n) * 2 + 1]; }
    }
    __syncthreads();
    for (int i = tid; i < 1024; i += NTHREADS) {
        const int n = i >> 4, c = i & 15; const float br = inp(I_BRE)[(g * 64 + n) * 16 + c], bi = inp(I_BIM)[(g * 64 + n) * 16 + c], fr = FF[2 * n], fi = FF[2 * n + 1];
        BP[i * 2] = fr * br - fi * bi; BP[i * 2 + 1] = fr * bi + fi * br;
        const int c2 = i >> 6, n2 = i & 63; CC[i * 2] = inp(I_CRE)[(g * 16 + c2) * 64 + n2]; CC[i * 2 + 1] = inp(I_CIM)[(g * 16 + c2) * 64 + n2];
    }
    __syncthreads();
    for (int i = tid; i < 2048; i += NTHREADS) {
        const int d = i >> 6, c = 4 * part + ((i >> 4) & 3), cp = i & 15; float a = 0.f;
        for (int n = 0; n < 64; ++n) {
            const f32x2 cv = *(const LAS f32x2*)(CC + (c * 64 + n) * 2), pv = *(const LAS f32x2*)(PW + (d * 64 + n) * 2), bv = *(const LAS f32x2*)(BP + (n * 16 + cp) * 2);
            const float tr = cv.x * pv.x - cv.y * pv.y, ti = cv.x * pv.y + cv.y * pv.x;
            a += tr * bv.x - ti * bv.y;
        }
        KD[i] = a;
    }
    __syncthreads();
    bf16_t* BtY = (bf16_t*)(F.ws + WS_BTY) + (size_t)g * 512 * 640;
    for (int id = tid; id < 128 * 80; id += NTHREADS) {
        const int rl = id / 80, ch = id % 80, t = rl >> 2, cl = rl & 3, c = 4 * part + cl, row = t * 16 + c; float v[8];
        if (ch < 64) { const int j = ch >> 1, cp0 = (ch & 1) * 8;
#pragma unroll
            for (int q = 0; q < 8; ++q) v[q] = (j <= t) ? KD[((t - j) * 4 + cl) * 16 + cp0 + q] : 0.f;
        } else { const int nn0 = (ch - 64) * 8;
#pragma unroll
            for (int q = 0; q < 8; ++q) { const int nn = nn0 + q, n = nn & 63; const f32x2 cv = *(const LAS f32x2*)(CC + (c * 64 + n) * 2), pv = *(const LAS f32x2*)(PW + ((t + 1) * 64 + n) * 2);
                v[q] = (nn < 64) ? (cv.x * pv.x - cv.y * pv.y) : -(cv.x * pv.y + cv.y * pv.x); }
        }
        u32x4 o; o.x = pkbf(v[0], v[1]); o.y = pkbf(v[2], v[3]); o.z = pkbf(v[4], v[5]); o.w = pkbf(v[6], v[7]);
        *(u32x4*)(BtY + (size_t)row * 640 + ch * 8) = o;
    }
    bf16_t* BtV = (bf16_t*)(F.ws + WS_BTV) + (size_t)g * 256 * 512;
    for (int id = tid; id < 64 * 64; id += NTHREADS) {
        const int row = 64 * part + (id >> 6), ch = id & 63, j = ch >> 1, cp0 = (ch & 1) * 8, n = row & 63; float v[8];
#pragma unroll
        for (int q = 0; q < 8; ++q) { const f32x2 pv = *(const LAS f32x2*)(PW + ((31 - j) * 64 + n) * 2), bv = *(const LAS f32x2*)(BP + (n * 16 + cp0 + q) * 2);
            v[q] = (row < 64) ? (pv.x * bv.x - pv.y * bv.y) : (row < 128) ? (pv.x * bv.y + pv.y * bv.x) : 0.f; }
        u32x4 o; o.x = pkbf(v[0], v[1]); o.y = pkbf(v[2], v[3]); o.z = pkbf(v[4], v[5]); o.w = pkbf(v[6], v[7]);
        *(u32x4*)(BtV + (size_t)row * 512 + ch * 8) = o;
    }
    __syncthreads();
}

__device__ __forceinline__ int p0_grab(unsigned* ctr, int n) { int v = 0; if ((otid() & 63) == 0) v = (int)__hip_atomic_fetch_add(ctr, (unsigned)n, __ATOMIC_RELAXED, __HIP_MEMORY_SCOPE_AGENT); return __builtin_amdgcn_readfirstlane(v); }
__device__ __forceinline__ void p0_prologue(Frame& F) {
    const int tid_o = otid(), lane_o = tid_o & 63;
    const int gw = F.vcu * NWAVES + F.wave, NGW = F.G * NWAVES;
#pragma nounroll
    for (int st = 0; st < 2; ++st) {
    if ((st == 0) == (((int)blockIdx.x & 1) == 0)) { for (int it = blockIdx.x; it < 4 * S5G; it += F.G) p0_s5_group(F, it >> 2, it & 3); }
    else {
    {
        const int* pos = (const int*)inp(I_POS); float* rope = (float*)(F.ws + WS_ROPE);
        const int gt = F.vcu * NTHREADS + tid_o, NGT = F.G * NTHREADS;
        for (int i = gt; i < T * 64; i += NGT) {
            const int tok = i >> 6, dh = i & 63;
            double f = 1.0; { double b = 0.86596432336006535; int e = dh; while (e) { if (e & 1) f *= b; b *= b; e >>= 1; } }
            double s, c; sincos_d((double)pos[tok] * f, s, c);
            rope[(size_t)tok * 128 + dh] = (float)c; rope[(size_t)tok * 128 + 64 + dh] = (float)s;
        }
    }
    {
        const float* gg = inp(I_NMG); f32x4 gv[4];
#pragma unroll
        for (int j = 0; j < 4; ++j) gv[j] = *((const f32x4*)gg + lane_o + 64 * j);
        for (int m = gw; m < T; m += NGW) {
            const f32x4* xr = (const f32x4*)(inp(I_X) + (size_t)m * DM) + lane_o; f32x4 v[4]; float s = 0.f;
#pragma unroll
            for (int j = 0; j < 4; ++j) { v[j] = __builtin_nontemporal_load(xr + 64 * j); s += (v[j].x * v[j].x + v[j].y * v[j].y) + (v[j].z * v[j].z + v[j].w * v[j].w); }
            const float rs = 1.0f / sqrtf(wave_sum(s) * (1.f / DM) + NORM_EPS);
            u32x2* o8 = (u32x2*)((bf16_t*)(F.ws + WS_H) + (size_t)m * DM) + lane_o;
            unsigned* o4 = (unsigned*)((unsigned char*)(F.ws + WS_H8) + (size_t)m * DM) + lane_o;
#pragma unroll
            for (int j = 0; j < 4; ++j) { const f32x4 hh = v[j] * rs * gv[j]; u32x2 o; o.x = pkbf(hh.x, hh.y); o.y = pkbf(hh.z, hh.w); o8[64 * j] = o; o4[64 * j] = pkfp8x4(hh.x, hh.y, hh.z, hh.w); }
        }
    }
    }
    }
    LAS float* scr = (LAS float*)(F.lds + F.wave * 16384);
    constexpr int I_IN = (DM / 64) * (INW / 32), I_GLU = (512 / 64) * (512 / 32), I_BS5 = (512 / 64) * (1024 / 32), I_SQ = (1024 / 64) * (1024 / 32);
    constexpr int I_E1 = (1024 / 64) * (2048 / 32), I_E2 = I_SQ;
    constexpr int NITEMS = I_IN + I_GLU + I_BS5 + 2 * I_SQ + NE * (I_E1 + I_E2), CHUNK = 8;
    unsigned* qctr = F.ctl + CW_QUEUE;
    int base = p0_grab(qctr, CHUNK);
    while (base < NITEMS) {
        const int nbase = p0_grab(qctr, CHUNK);
        const int end = (base + CHUNK < NITEMS) ? base + CHUNK : NITEMS;
        for (int it = base; it < end; ++it) {
            int r = it;
            if (r < NE * I_E1) { const int e = r / I_E1; p0_transpose_item_fp8<1>(inp(I_W1) + (size_t)e * 1024 * 2048, 1024, 2048, (unsigned char*)(F.ws + WS_W1) + (size_t)e * 2048 * 1024, scr, r % I_E1, lane_o); continue; } r -= NE * I_E1;
            if (r < NE * I_E2) { const int e = r / I_E2; p0_transpose_item_fp8<3>(inp(I_W2) + (size_t)e * 1024 * 1024, 1024, 1024, (unsigned char*)(F.ws + WS_W2) + (size_t)e * 1024 * 1024, scr, r % I_E2, lane_o); continue; } r -= NE * I_E2;
            if (r < I_IN) { if ((r % (INW / 32)) < 256 * IN_BF_TILES / 32) p0_transpose_item<true>(inp(I_WIN), DM, INW, (bf16_t*)(F.ws + WS_WIN), scr, r, lane_o, DM);
                            else p0_transpose_item_fp8<2>(inp(I_WIN), DM, INW, (unsigned char*)(F.ws + WS_WIN8), scr, r, lane_o); continue; } r -= I_IN;
            if (r < I_GLU) { p0_transpose_item<false>(inp(I_WGLU), 512, 512, (bf16_t*)(F.ws + WS_WGLU), scr, r, lane_o, 512); continue; } r -= I_GLU;
            if (r < I_BS5) { p0_transpose_item<false>(inp(I_WBS5), 512, 1024, (bf16_t*)(F.ws + WS_WCAT), scr, r, lane_o, 1536); continue; } r -= I_BS5;
            if (r < I_SQ) { p0_transpose_item<false>(inp(I_WBRET), 1024, 1024, (bf16_t*)(F.ws + WS_WCAT) + 512, scr, r, lane_o, 1536); continue; } r -= I_SQ;
            p0_transpose_item<false>(inp(I_WOUT), 1024, 1024, (bf16_t*)(F.ws + WS_WOUT), scr, r, lane_o, 1024);
        }
        base = nbase;
    }
}

typedef const f32x4 (&AccRef)[2][2][4][2];
struct Pre0 {};
struct Pre16 { f32x4 v[4]; };
#define EPI_ROWS(...) _Pragma("unroll") for (int ai = 0; ai < 2; ++ai) { _Pragma("unroll") for (int m = 0; m < 4; ++m) { const int rloc = ai * 128 + wr * 64 + m * 16 + fr; _Pragma("unroll") for (int bj = 0; bj < 2; ++bj) { const int cloc = bj * 128 + wc * 32 + 8 * fq; const f32x4 v0 = acc[ai][bj][m][0], v1 = acc[ai][bj][m][1]; __VA_ARGS__ } } asm volatile("" ::: "memory"); }

__device__ __forceinline__ float l2gamma(int h) { return h == 0 ? -0.04580368961312479f : h == 1 ? -0.02272007650008353f : h == 2 ? -0.011315313227834146f : -0.005646563141142063f; }

template <bool GATES> struct EpiInProj {
    static constexpr bool PERM = true, FP8 = GATES;
    unsigned char* ws;
    typedef Pre0 Pre; __device__ __forceinline__ Pre prefetch(const Unit&, int, int, int, int) const { return Pre(); }
    __device__ __forceinline__ void operator()(AccRef acc, const Unit& u, int wr, int wc, int fr, int fq, const Pre&) const {
        const int ct = u.pn + (GATES ? IN_BF_TILES : 0); constexpr int LO = GATES ? IN_BF_TILES : 0, HI = GATES ? 22 : IN_BF_TILES;
        if (LO < 2 && ct < 2) {
            bf16_t* AS5 = (bf16_t*)(ws + WS_AS5);
            EPI_ROWS({ const int row = u.pm * 256 + rloc, col = ct * 256 + cloc, g = col >> 4, c0 = col & 15, b = row >> 13, t = row & 8191;
                u32x4 o; o.x = pkbf(v0[0], v0[1]); o.y = pkbf(v0[2], v0[3]); o.z = pkbf(v1[0], v1[1]); o.w = pkbf(v1[2], v1[3]);
                *(u32x4*)(AS5 + ((size_t)(g * 1024 + b * 256 + (t >> 5)) * 640 + (t & 31) * 16 + c0)) = o; })
        } else if (LO < 6 && HI > 2 && ct < 6) {
            const bool isk = ct >= 4; const float* rope = (const float*)(ws + WS_ROPE);
            bf16_t* QK = (bf16_t*)(ws + (isk ? WS_K : WS_Q));
            const int p0 = wc * 32 + 8 * fq, dh0 = p0 >> 1;
#pragma unroll
            for (int ai = 0; ai < 2; ++ai) { f32x4 cs[4], sn[4];
#pragma unroll
                for (int m = 0; m < 4; ++m) { const int row = u.pm * 256 + ai * 128 + wr * 64 + m * 16 + fr; cs[m] = *(const f32x4*)(rope + (size_t)row * 128 + dh0); sn[m] = *(const f32x4*)(rope + (size_t)row * 128 + 64 + dh0); }
#pragma unroll
                for (int m = 0; m < 4; ++m) { const int row = u.pm * 256 + ai * 128 + wr * 64 + m * 16 + fr; const float e = (float)((row & 127) + 1);
#pragma unroll
                    for (int bj = 0; bj < 2; ++bj) { const int hh = ((ct & 1) << 1) + bj; const float lg = l2gamma(hh); const f32x4 v0 = acc[ai][bj][m][0], v1 = acc[ai][bj][m][1];
                        const float sc = isk ? __builtin_amdgcn_exp2f(-lg * e) * 0.08838834764831845f : __builtin_amdgcn_exp2f(lg * e);
                        const f32x4 o1 = (v0 * cs[m] - v1 * sn[m]) * sc, o2 = (v1 * cs[m] + v0 * sn[m]) * sc;
                        u32x4 o; o.x = pkbf(o1[0], o1[1]); o.y = pkbf(o1[2], o1[3]); o.z = pkbf(o2[0], o2[1]); o.w = pkbf(o2[2], o2[3]);
                        *(u32x4*)(QK + (size_t)row * 512 + hh * 128 + p0) = o; } }
                asm volatile("" ::: "memory"); }
        } else if (LO < 10 && HI > 6 && ct < 10) {
            bf16_t* V = (bf16_t*)(ws + WS_V);
            EPI_ROWS({ const int row = u.pm * 256 + rloc, col = (ct - 6) * 256 + cloc;
                u32x4 o; o.x = pkbf(v0[0], v0[1]); o.y = pkbf(v0[2], v0[3]); o.z = pkbf(v1[0], v1[1]); o.w = pkbf(v1[2], v1[3]);
                *(u32x4*)(V + (size_t)row * 1024 + col) = o; })
        } else if (HI > 10) {
            const bool is_silu = ct < 14; bf16_t* SG = (bf16_t*)(ws + (ct < 14 ? WS_GS : ct < 18 ? WS_SA : WS_SB)); const int cb = ((ct - 10) & 3) * 256;
            if (is_silu) {
                EPI_ROWS({ const int row = u.pm * 256 + rloc, col = cb + cloc; f32x4 a0 = v0, a1 = v1; asm volatile("" : "+v"(a0), "+v"(a1));
                    const f32x2 x0 = {a0[0], a0[1]}, x1 = {a0[2], a0[3]}, x2 = {a1[0], a1[1]}, x3 = {a1[2], a1[3]};
                    const f32x2 y0 = x0 * fsigmoid2(x0), y1 = x1 * fsigmoid2(x1), y2 = x2 * fsigmoid2(x2), y3 = x3 * fsigmoid2(x3);
                    u32x4 o; o.x = pkbf(y0.x, y0.y); o.y = pkbf(y1.x, y1.y); o.z = pkbf(y2.x, y2.y); o.w = pkbf(y3.x, y3.y);
                    __builtin_nontemporal_store(o, (u32x4*)(SG + (size_t)row * 1024 + col)); })
            } else {
                unsigned char* SG8 = (unsigned char*)SG;
                EPI_ROWS({ const int row = u.pm * 256 + rloc, col = cb + cloc; f32x4 a0 = v0, a1 = v1; asm volatile("" : "+v"(a0), "+v"(a1));
                    const f32x2 y0 = fsigmoid2(f32x2{a0[0], a0[1]}) * 254.f + 1.f, y1 = fsigmoid2(f32x2{a0[2], a0[3]}) * 254.f + 1.f, y2 = fsigmoid2(f32x2{a1[0], a1[1]}) * 254.f + 1.f, y3 = fsigmoid2(f32x2{a1[2], a1[3]}) * 254.f + 1.f;
                    u32x2 o; o.x = __builtin_amdgcn_cvt_pk_u8_f32(y1.y, 3, __builtin_amdgcn_cvt_pk_u8_f32(y1.x, 2, __builtin_amdgcn_cvt_pk_u8_f32(y0.y, 1, __builtin_amdgcn_cvt_pk_u8_f32(y0.x, 0, 0u))));
                    o.y = __builtin_amdgcn_cvt_pk_u8_f32(y3.y, 3, __builtin_amdgcn_cvt_pk_u8_f32(y3.x, 2, __builtin_amdgcn_cvt_pk_u8_f32(y2.y, 1, __builtin_amdgcn_cvt_pk_u8_f32(y2.x, 0, 0u))));
                    __builtin_nontemporal_store(o, (u32x2*)(SG8 + (size_t)row * 1024 + col)); })
            }
        }
    }
};

struct EpiS5V {
    static constexpr bool PERM = false, FP8 = false;
    float* VB;
    typedef Pre0 Pre; __device__ __forceinline__ Pre prefetch(const Unit&, int, int, int, int) const { return Pre(); }
    __device__ __forceinline__ void operator()(AccRef acc, const Unit& u, int wr, int wc, int fr, int fq, const Pre&) const {
#pragma unroll
        for (int ai = 0; ai < 2; ++ai)
#pragma unroll
            for (int m = 0; m < 4; ++m) { const int r = u.pm * 256 + ai * 128 + wr * 64 + m * 16 + fr; float* rp = VB + ((size_t)(u.aux * 1024 + r)) * 128 + wc * 32 + 4 * fq;
#pragma unroll
                for (int n = 0; n < 2; ++n) *(f32x4*)(rp + n * 16) = acc[ai][0][m][n]; }
    }
};

struct EpiS5Y {
    static constexpr bool PERM = true, FP8 = false;
    const bf16_t* AS5; bf16_t* Z; const float* dsk;
    typedef Pre0 Pre; __device__ __forceinline__ Pre prefetch(const Unit&, int, int, int, int) const { return Pre(); }
    __device__ __forceinline__ void operator()(AccRef acc, const Unit& u, int wr, int wc, int fr, int fq, const Pre&) const {
        const int g = u.aux;
        EPI_ROWS({ const int r = u.pm * 256 + rloc, col = u.pn * 256 + cloc, b = r >> 8, ch = r & 255, tl = col >> 4, c0 = col & 15, tok = b * 8192 + ch * 32 + tl;
            const u32x4 uu = *(const u32x4*)(AS5 + ((size_t)(g * 1024 + r)) * 640 + col);
            const f32x4 d0 = *(const f32x4*)(dsk + g * 16 + c0), d1 = *(const f32x4*)(dsk + g * 16 + c0 + 4);
            f32x2 y[4] = { f32x2{v0[0], v0[1]} + f32x2{d0[0], d0[1]} * f32x2{bflo(uu.x), bfhi(uu.x)}, f32x2{v0[2], v0[3]} + f32x2{d0[2], d0[3]} * f32x2{bflo(uu.y), bfhi(uu.y)},
                           f32x2{v1[0], v1[1]} + f32x2{d1[0], d1[1]} * f32x2{bflo(uu.z), bfhi(uu.z)}, f32x2{v1[2], v1[3]} + f32x2{d1[2], d1[3]} * f32x2{bflo(uu.w), bfhi(uu.w)} };
            _Pragma("unroll") for (int q = 0; q < 4; ++q) { const f32x2 a = (y[q] + (y[q] * y[q]) * y[q] * 0.044715f) * 0.7978845608028654f; y[q] = y[q] * fsigmoid2(a * 2.0f); }
            u32x4 o; o.x = pkbf(y[0].x, y[0].y); o.y = pkbf(y[1].x, y[1].y); o.z = pkbf(y[2].x, y[2].y); o.w = pkbf(y[3].x, y[3].y);
            *(u32x4*)(Z + (size_t)tok * 512 + g * 16 + c0) = o; })
    }
};

struct EpiGlu {
    static constexpr bool PERM = true, FP8 = false;
    const bf16_t* Z; bf16_t* Y; const float* bg;
    typedef Pre0 Pre; __device__ __forceinline__ Pre prefetch(const Unit&, int, int, int, int) const { return Pre(); }
    __device__ __forceinline__ void operator()(AccRef acc, const Unit& u, int wr, int wc, int fr, int fq, const Pre&) const {
        EPI_ROWS({ const int row = u.pm * 256 + rloc, col = u.pn * 256 + cloc;
            const u32x4 zz = __builtin_nontemporal_load((const u32x4*)(Z + (size_t)row * 512 + col)); const f32x4 b0 = *(const f32x4*)(bg + col), b1 = *(const f32x4*)(bg + col + 4);
            const f32x2 y0 = f32x2{bflo(zz.x), bfhi(zz.x)} * fsigmoid2(f32x2{v0[0], v0[1]} + f32x2{b0[0], b0[1]}), y1 = f32x2{bflo(zz.y), bfhi(zz.y)} * fsigmoid2(f32x2{v0[2], v0[3]} + f32x2{b0[2], b0[3]});
            const f32x2 y2 = f32x2{bflo(zz.z), bfhi(zz.z)} * fsigmoid2(f32x2{v1[0], v1[1]} + f32x2{b1[0], b1[1]}), y3 = f32x2{bflo(zz.w), bfhi(zz.w)} * fsigmoid2(f32x2{v1[2], v1[3]} + f32x2{b1[2], b1[3]});
            u32x4 o; o.x = pkbf(y0.x, y0.y); o.y = pkbf(y1.x, y1.y); o.z = pkbf(y2.x, y2.y); o.w = pkbf(y3.x, y3.y);
            *(u32x4*)(Y + (size_t)row * 512 + col) = o; })
    }
};

struct EpiChain {
    static constexpr bool PERM = true, FP8 = false;
    const unsigned char* SA; const unsigned char* SB; bf16_t* O;
    typedef Pre0 Pre; __device__ __forceinline__ Pre prefetch(const Unit&, int, int, int, int) const { return Pre(); }
    static __device__ __forceinline__ float ub(unsigned w, int k) { return (float)((w >> (8 * k)) & 255u); }
    __device__ __forceinline__ void operator()(f32x4 (&acc)[2][2][4][2], const Unit& u, int wr, int wc, int fr, int fq, const Pre&) const {
        if (u.seg == 0) {
#pragma unroll
            for (int ai = 0; ai < 2; ++ai) {
#pragma unroll
                for (int m = 0; m < 4; ++m)
#pragma unroll
                    for (int bj = 0; bj < 2; ++bj) { const size_t off = (size_t)(u.pm * 256 + ai * 128 + wr * 64 + m * 16 + fr) * 1024 + u.pn * 256 + bj * 128 + wc * 32 + 8 * fq;
                        const u32x2 a = __builtin_nontemporal_load((const u32x2*)(SA + off)); const u32x2 b = *(const u32x2*)(SB + off);
                        f32x4& v0 = acc[ai][bj][m][0]; f32x4& v1 = acc[ai][bj][m][1];
                        v0[0] *= ub(a.x, 0) * __builtin_amdgcn_rcpf(ub(b.x, 0)); v0[1] *= ub(a.x, 1) * __builtin_amdgcn_rcpf(ub(b.x, 1)); v0[2] *= ub(a.x, 2) * __builtin_amdgcn_rcpf(ub(b.x, 2)); v0[3] *= ub(a.x, 3) * __builtin_amdgcn_rcpf(ub(b.x, 3));
                        v1[0] *= ub(a.y, 0) * __builtin_amdgcn_rcpf(ub(b.y, 0)); v1[1] *= ub(a.y, 1) * __builtin_amdgcn_rcpf(ub(b.y, 1)); v1[2] *= ub(a.y, 2) * __builtin_amdgcn_rcpf(ub(b.y, 2)); v1[3] *= ub(a.y, 3) * __builtin_amdgcn_rcpf(ub(b.y, 3)); }
                asm volatile("" ::: "memory"); }
        } else {
            constexpr float I255 = 1.0f / 255.0f;
#pragma unroll
            for (int ai = 0; ai < 2; ++ai) { u32x2 sv[4][2];
#pragma unroll
                for (int m = 0; m < 4; ++m)
#pragma unroll
                    for (int bj = 0; bj < 2; ++bj) sv[m][bj] = __builtin_nontemporal_load((const u32x2*)(SB + (size_t)(u.pm * 256 + ai * 128 + wr * 64 + m * 16 + fr) * 1024 + u.pn * 256 + bj * 128 + wc * 32 + 8 * fq));
#pragma unroll
                for (int m = 0; m < 4; ++m)
#pragma unroll
                    for (int bj = 0; bj < 2; ++bj) { const size_t off = (size_t)(u.pm * 256 + ai * 128 + wr * 64 + m * 16 + fr) * 1024 + u.pn * 256 + bj * 128 + wc * 32 + 8 * fq;
                        const u32x2 s = sv[m][bj]; const f32x4 v0 = acc[ai][bj][m][0] * I255, v1 = acc[ai][bj][m][1] * I255;
                        u32x4 o; o.x = pkbf(v0[0] * ub(s.x, 0), v0[1] * ub(s.x, 1)); o.y = pkbf(v0[2] * ub(s.x, 2), v0[3] * ub(s.x, 3)); o.z = pkbf(v1[0] * ub(s.y, 0), v1[1] * ub(s.y, 1)); o.w = pkbf(v1[2] * ub(s.y, 2), v1[3] * ub(s.y, 3));
                        *(u32x4*)(O + off) = o; }
                asm volatile("" ::: "memory"); }
        }
    }
};

struct EpiResid {
    static constexpr bool PERM = true, FP8 = false;
    const float* X; bf16_t* O; float* RSS;
    typedef Pre0 Pre; __device__ __forceinline__ Pre prefetch(const Unit&, int, int, int, int) const { return Pre(); }
    __device__ __forceinline__ void operator()(AccRef acc, const Unit& u, int wr, int wc, int fr, int fq, const Pre&) const {
#pragma unroll
        for (int ai = 0; ai < 2; ++ai)
#pragma unroll
            for (int m = 0; m < 4; ++m) { const int row = u.pm * 256 + ai * 128 + wr * 64 + m * 16 + fr; const size_t off = (size_t)row * 1024 + u.pn * 256 + wc * 32 + 8 * fq; float ss = 0.f;
#pragma unroll
                for (int bj = 0; bj < 2; ++bj) { const f32x4 o0 = __builtin_nontemporal_load((const f32x4*)(X + off + bj * 128)) + acc[ai][bj][m][0], o1 = __builtin_nontemporal_load((const f32x4*)(X + off + bj * 128 + 4)) + acc[ai][bj][m][1];
                    u32x4 o; o.x = pkbf(o0[0], o0[1]); o.y = pkbf(o0[2], o0[3]); o.z = pkbf(o1[0], o1[1]); o.w = pkbf(o1[2], o1[3]); *(u32x4*)(O + off + bj * 128) = o;
                    ss += ((o0[0] * o0[0] + o0[1] * o0[1]) + (o0[2] * o0[2] + o0[3] * o0[3])) + ((o1[0] * o1[0] + o1[1] * o1[1]) + (o1[2] * o1[2] + o1[3] * o1[3])); }
                ss += __shfl_xor(ss, 16); ss += __shfl_xor(ss, 32);
                if (fq == 0) RSS[(size_t)row * 16 + u.pn * 4 + wc] = ss;
                if (m == 3) asm volatile("" ::: "memory"); }
    }
};

struct EpiSwiglu {
    static constexpr bool PERM = true, FP8 = true;
    const float* b1; unsigned char* ACT;
    typedef Pre16 Pre;
    __device__ __forceinline__ Pre prefetch(const Unit& u, int wr, int wc, int fr, int fq) const { const float* bb = b1 + (size_t)u.aux * 2048 + 2 * (u.pn * 128 + wc * 32 + 8 * fq); Pre p;
        p.v[0] = *(const f32x4*)(bb); p.v[1] = *(const f32x4*)(bb + 4); p.v[2] = *(const f32x4*)(bb + 8); p.v[3] = *(const f32x4*)(bb + 12); return p; }
    __device__ __forceinline__ void operator()(AccRef acc, const Unit& u, int wr, int wc, int fr, int fq, const Pre& pre) const {
        const int j0 = u.pn * 128 + wc * 32 + 8 * fq;
        const f32x4 q0 = pre.v[0], q1 = pre.v[1], q2 = pre.v[2], q3 = pre.v[3];
        const f32x2 bg[4] = {{q0[0], q0[2]}, {q1[0], q1[2]}, {q2[0], q2[2]}, {q3[0], q3[2]}};
        const f32x2 bl[4] = {f32x2{q0[1], q0[3]} + 1.f, f32x2{q1[1], q1[3]} + 1.f, f32x2{q2[1], q2[3]} + 1.f, f32x2{q3[1], q3[3]} + 1.f};
#pragma unroll
        for (int ai = 0; ai < 2; ++ai)
#pragma unroll
            for (int m = 0; m < 4; ++m) { const int row = u.pm * 256 + ai * 128 + wr * 64 + m * 16 + fr;
                const f32x4 g0 = acc[ai][0][m][0], g1 = acc[ai][0][m][1], l0 = acc[ai][1][m][0], l1 = acc[ai][1][m][1];
                const f32x2 gg[4] = {{g0[0], g0[1]}, {g0[2], g0[3]}, {g1[0], g1[1]}, {g1[2], g1[3]}}, ll[4] = {{l0[0], l0[1]}, {l0[2], l0[3]}, {l1[0], l1[1]}, {l1[2], l1[3]}}; f32x2 r[4];
#pragma unroll
                for (int q = 0; q < 4; ++q) { f32x2 xg = gg[q] + bg[q], xl = ll[q] + bl[q];
                    xg.x = __builtin_amdgcn_fmed3f(xg.x, -40.f, 7.f); xg.y = __builtin_amdgcn_fmed3f(xg.y, -40.f, 7.f);
                    xl.x = __builtin_amdgcn_fmed3f(xl.x, -6.f, 8.f); xl.y = __builtin_amdgcn_fmed3f(xl.y, -6.f, 8.f);
                    const f32x2 t = xg * -2.4554669595930157f;
                    const f32x2 d = f32x2{__builtin_amdgcn_exp2f(t.x), __builtin_amdgcn_exp2f(t.y)} + 1.0f;
                    const float rp = __builtin_amdgcn_rcpf(d.x * d.y);
                    r[q] = (xg * (f32x2{d.y, d.x} * rp)) * xl; }
                u32x2 o; o.x = pkfp8x4(r[0].x, r[0].y, r[1].x, r[1].y); o.y = pkfp8x4(r[2].x, r[2].y, r[3].x, r[3].y);
                *(u32x2*)(ACT + (size_t)row * 1024 + j0) = o; }
    }
};
struct EpiExpOut {
    static constexpr bool PERM = true, FP8 = true; static constexpr int NST = 0;
    const float* b2; unsigned char* YK;
    typedef Pre16 Pre;
    __device__ __forceinline__ Pre prefetch(const Unit& u, int wr, int wc, int fr, int fq) const { const float* bb = b2 + (size_t)u.aux * 1024 + u.pn * 256 + 64 * wc + 16 * fq; Pre p;
        p.v[0] = *(const f32x4*)(bb); p.v[1] = *(const f32x4*)(bb + 4); p.v[2] = *(const f32x4*)(bb + 8); p.v[3] = *(const f32x4*)(bb + 12); return p; }
    __device__ __forceinline__ void operator()(AccRef acc, const Unit& u, int wr, int wc, int fr, int fq, const Pre& pre) const {
        const int lb = u.pn * 256 + 64 * wc + 16 * fq;
        const f32x4 b0 = pre.v[0], b1 = pre.v[1], b2v = pre.v[2], b3 = pre.v[3];
#pragma unroll
        for (int r = 0; r < 8; ++r) { const int ai = r >> 2, m = r & 3, row = u.pm * 256 + ai * 128 + wr * 64 + m * 16 + fr;
            const f32x4 a0 = acc[ai][0][m][0] + b0, a1 = acc[ai][0][m][1] + b1, a2 = acc[ai][1][m][0] + b2v, a3 = acc[ai][1][m][1] + b3;
            u32x4 o; o.x = pkfp8x4(a0[0], a0[1], a0[2], a0[3]); o.y = pkfp8x4(a1[0], a1[1], a1[2], a1[3]); o.z = pkfp8x4(a2[0], a2[1], a2[2], a2[3]); o.w = pkfp8x4(a3[0], a3[1], a3[2], a3[3]);
            *(u32x4*)(YK + (size_t)row * 1024 + lb) = o; }
    }
};

constexpr int RSTR = 272;
__device__ __forceinline__ bf16x8 lds_frag(const LAS unsigned char* base, int row0, int k0, int fr, int fq) { return *(const LAS bf16x8*)(base + (row0 + fr) * RSTR + (k0 + 8 * fq) * 2); }

typedef short s16x4 __attribute__((ext_vector_type(4)));
__device__ __forceinline__ bf16x8 tr_frag(const LAS unsigned char* p, int rowstride) {
    const s16x4 lo = __builtin_bit_cast(s16x4, __builtin_amdgcn_ds_read_tr16_b64_v4i16((LAS s16x4*)(p)));
    const s16x4 hi = __builtin_bit_cast(s16x4, __builtin_amdgcn_ds_read_tr16_b64_v4i16((LAS s16x4*)(p + 16 * rowstride)));
    return (bf16x8){lo[0], lo[1], lo[2], lo[3], hi[0], hi[1], hi[2], hi[3]};
}
constexpr int KSTR_A = 288, VSTR = 544;

__device__ __forceinline__ void ret_pass_a(Frame& F) {
    const int tid_o = otid(), lane_o = tid_o & 63;
    const int tid = tid_o, wid = F.wave, lane = lane_o, fr = lane & 15, fq = lane >> 4;
    const bf16_t* Kb = (const bf16_t*)(F.ws + WS_K); const bf16_t* V = (const bf16_t*)(F.ws + WS_V); bf16_t* KV = (bf16_t*)(F.ws + WS_KV);
    LAS unsigned char* sK = F.lds; LAS unsigned char* sV = F.lds + 128 * KSTR_A;
    const int trow = 4 * fq + (fr >> 2), tcol = 4 * (fr & 3);
    constexpr int NIT = 16 * (RNC - 1);
    int it = blockIdx.x; if (it >= NIT) return;
    u32x4 kr[4], vr[8];
#define RA_LOAD(item) do { const int bh_ = (item) / (RNC - 1), c_ = (item) % (RNC - 1), tok_ = (bh_ >> 2) * 8192 + c_ * 128, h_ = bh_ & 3; \
        _Pragma("unroll") for (int i = 0; i < 4; ++i) { const int id = tid + NTHREADS * i; kr[i] = *(const u32x4*)(Kb + ((size_t)(tok_ + (id >> 4))) * 512 + h_ * 128 + (id & 15) * 8); } \
        _Pragma("unroll") for (int i = 0; i < 8; ++i) { const int id = tid + NTHREADS * i; vr[i] = *(const u32x4*)(V + ((size_t)(tok_ + (id >> 5))) * 1024 + h_ * 256 + (id & 31) * 8); } } while (0)
    RA_LOAD(it);
    for (;;) {
        const int bh = it / (RNC - 1), c = it % (RNC - 1);
#pragma unroll
        for (int i = 0; i < 4; ++i) { const int id = tid + NTHREADS * i; *(LAS u32x4*)(sK + (id >> 4) * KSTR_A + (id & 15) * 16) = kr[i]; }
#pragma unroll
        for (int i = 0; i < 8; ++i) { const int id = tid + NTHREADS * i; *(LAS u32x4*)(sV + (id >> 5) * VSTR + (id & 31) * 16) = vr[i]; }
        LDS_BARRIER();
        const int nit = it + F.G; const bool has = nit < NIT;
        if (has) RA_LOAD(nit);
        f32x4 acc[2][8];
#pragma unroll
        for (int mt = 0; mt < 2; ++mt)
#pragma unroll
            for (int nt = 0; nt < 8; ++nt) acc[mt][nt] = (f32x4){0.f, 0.f, 0.f, 0.f};
#pragma unroll
        for (int ks = 0; ks < 4; ++ks) {
            bf16x8 vf[2];
#pragma unroll
            for (int mt = 0; mt < 2; ++mt) vf[mt] = tr_frag(sV + (ks * 32 + trow) * VSTR + (wid * 32 + mt * 16 + tcol) * 2, VSTR);
#pragma unroll
            for (int nt = 0; nt < 8; ++nt) { const bf16x8 kf = tr_frag(sK + (ks * 32 + trow) * KSTR_A + (nt * 16 + tcol) * 2, KSTR_A);
#pragma unroll
                for (int mt = 0; mt < 2; ++mt) acc[mt][nt] = __builtin_amdgcn_mfma_f32_16x16x32_bf16(kf, vf[mt], acc[mt][nt], 0, 0, 0); }
        }
        LDS_BARRIER();
        LAS unsigned char* stg = sV + wid * (32 * 272);
#pragma unroll
        for (int mt = 0; mt < 2; ++mt)
#pragma unroll
            for (int nt = 0; nt < 8; ++nt) { u32x2 w; w.x = pkbf(acc[mt][nt][0], acc[mt][nt][1]); w.y = pkbf(acc[mt][nt][2], acc[mt][nt][3]); *(LAS u32x2*)(stg + (mt * 16 + fr) * 272 + (nt * 16 + 4 * fq) * 2) = w; }
        LDS_WAIT(); asm volatile("" ::: "memory");
        { bf16_t* o = KV + ((size_t)(bh * RNC + c)) * 32768 + (size_t)(wid * 32) * 128; int tg = lane; asm volatile("" : "+v"(tg));
#pragma unroll
          for (int i2 = 0; i2 < 8; ++i2) { const int id = tg + 64 * i2; *(u32x4*)(o + (id >> 4) * 128 + (id & 15) * 8) = *(const LAS u32x4*)(stg + (id >> 4) * 272 + (id & 15) * 16); } }
        LDS_BARRIER();
        if (!has) break;
        it = nit;
    }
#undef RA_LOAD
}

__device__ __forceinline__ void ret_pass_b(Frame& F) {
    const int tid_o = otid();
    const bf16_t* KV = (const bf16_t*)(F.ws + WS_KV); bf16_t* ST = (bf16_t*)(F.ws + WS_ST);
    if (tid_o >= 256) return;
    const bool g256 = (F.G == 256); const int nmine = g256 ? (F.vcu < 128 ? 192 : 320) : 256, base = g256 ? (F.vcu < 128 ? F.vcu * 192 : 128 * 192 + (F.vcu - 128) * 320) : F.vcu * 256, step = g256 ? 65536 : F.G * 256;
    for (int j = tid_o; j < nmine; j += 256) for (int i = base + j; i < 16 * 4096; i += step) {
        const int bh = i >> 12, e8 = i & 4095, h = bh & 3; const float gC = __builtin_amdgcn_exp2f(128.0f * l2gamma(h));
        float s[8];
#pragma unroll
        for (int q = 0; q < 8; ++q) s[q] = 0.f;
        const bf16_t* kp = KV + (size_t)bh * RNC * 32768 + e8 * 8; bf16_t* sp = ST + (size_t)bh * RNC * 32768 + e8 * 8;
#pragma unroll 8
        for (int c = 0; c < RNC; ++c) {
            u32x4 o; o.x = pkbf(s[0], s[1]); o.y = pkbf(s[2], s[3]); o.z = pkbf(s[4], s[5]); o.w = pkbf(s[6], s[7]); *(u32x4*)(sp + (size_t)c * 32768) = o;
            if (c < RNC - 1) { const u32x4 kv = __builtin_nontemporal_load((const u32x4*)(kp + (size_t)c * 32768));
                s[0] = (s[0] + bflo(kv.x)) * gC; s[1] = (s[1] + bfhi(kv.x)) * gC; s[2] = (s[2] + bflo(kv.y)) * gC; s[3] = (s[3] + bfhi(kv.y)) * gC;
                s[4] = (s[4] + bflo(kv.z)) * gC; s[5] = (s[5] + bfhi(kv.z)) * gC; s[6] = (s[6] + bflo(kv.w)) * gC; s[7] = (s[7] + bfhi(kv.w)) * gC; }
        }
    }
}

__device__ __forceinline__ void ret_pass_c(Frame& F) {
    const int tid_o = otid(), lane_o = tid_o & 63;
    const int tid = tid_o, wid = F.wave, lane = lane_o, fr = lane & 15, fq = lane >> 4;
    const bf16_t* Q = (const bf16_t*)(F.ws + WS_Q); const bf16_t* Kb = (const bf16_t*)(F.ws + WS_K); const bf16_t* V = (const bf16_t*)(F.ws + WS_V);
    const bf16_t* ST = (const bf16_t*)(F.ws + WS_ST); const bf16_t* GS = (const bf16_t*)(F.ws + WS_GS); bf16_t* RETG = (bf16_t*)(F.ws + WS_RETG);
    const float* gng = inp(I_GNG);
    LAS unsigned char* sK = F.lds;
    LAS unsigned char* sV = F.lds + 128 * RSTR;
    const int trow = 4 * fq + (fr >> 2), tcol = 4 * (fr & 3);
    constexpr int NIT = 16 * RNC;
    int it = blockIdx.x; if (it >= NIT) return;
    u32x4 kr[4], vr[8]; bf16x8 qf[4], qn[4];
#define RC_LOAD(item, qdst) do { int tl = tid; asm volatile("" : "+v"(tl)); const int bh_ = (item) / RNC, c_ = (item) % RNC, tok_ = (bh_ >> 2) * 8192 + c_ * 128, h_ = bh_ & 3; \
        _Pragma("unroll") for (int i = 0; i < 4; ++i) { const int id = tl + NTHREADS * i; kr[i] = __builtin_nontemporal_load((const u32x4*)(Kb + ((size_t)(tok_ + (id >> 4))) * 512 + h_ * 128 + (id & 15) * 8)); } \
        _Pragma("unroll") for (int i = 0; i < 8; ++i) { const int id = tl + NTHREADS * i; vr[i] = __builtin_nontemporal_load((const u32x4*)(V + ((size_t)(tok_ + (id >> 5))) * 1024 + h_ * 256 + (id & 31) * 8)); } \
        _Pragma("unroll") for (int ks = 0; ks < 4; ++ks) qdst[ks] = __builtin_nontemporal_load((const bf16x8*)(Q + ((size_t)(tok_ + wid * 16 + fr)) * 512 + h_ * 128 + ks * 32 + fq * 8)); } while (0)
    RC_LOAD(it, qf);
    for (;;) {
        const int bh = it / RNC, c = it % RNC, b = bh >> 2, h = bh & 3; const int tok0 = b * 8192 + c * 128;
        int tw = tid; asm volatile("" : "+v"(tw));
#pragma unroll
        for (int i = 0; i < 4; ++i) { const int id = tw + NTHREADS * i; *(LAS u32x4*)(sK + (id >> 4) * RSTR + (id & 15) * 16) = kr[i]; }
#pragma unroll
        for (int i = 0; i < 8; ++i) { const int id = tw + NTHREADS * i; *(LAS u32x4*)(sV + (id >> 5) * VSTR + (id & 31) * 16) = vr[i]; }
        LDS_BARRIER();
        u32x4 sr[8]; int ts = tid; asm volatile("" : "+v"(ts));
#pragma unroll
        for (int i = 0; i < 8; ++i) { const int id = ts + NTHREADS * i; sr[i] = __builtin_nontemporal_load((const u32x4*)(ST + ((size_t)(bh * RNC + c)) * 32768 + (id >> 4) * 128 + (id & 15) * 8)); }
        f32x4 sc[8];
#pragma unroll
        for (int nt = 0; nt < 8; ++nt) { sc[nt] = (f32x4){0.f, 0.f, 0.f, 0.f};
            if (nt <= wid) {
#pragma unroll
                for (int ks = 0; ks < 4; ++ks) sc[nt] = __builtin_amdgcn_mfma_f32_16x16x32_bf16(lds_frag(sK, nt * 16, ks * 32, fr, fq), qf[ks], sc[nt], 0, 0, 0);
                if (nt == wid) {
#pragma unroll
                    for (int r = 0; r < 4; ++r) if (4 * fq + r > fr) sc[nt][r] = 0.f;
                } } }
        LDS_BARRIER();
        LAS unsigned char* sP = sK + wid * 16 * RSTR;
#pragma unroll
        for (int nt = 0; nt < 8; ++nt) { u32x2 o; o.x = pkbf(sc[nt][0], sc[nt][1]); o.y = pkbf(sc[nt][2], sc[nt][3]); *(LAS u32x2*)(sP + fr * RSTR + (nt * 16 + 4 * fq) * 2) = o; }
        LDS_WAIT(); asm volatile("" ::: "memory");
        bf16x8 pf[4];
#pragma unroll
        for (int ks = 0; ks < 4; ++ks) { const u32x2 p0 = *(const LAS u32x2*)(sP + fr * RSTR + (ks * 32 + 4 * fq) * 2), p1 = *(const LAS u32x2*)(sP + fr * RSTR + (ks * 32 + 16 + 4 * fq) * 2);
            u32x4 pp; pp.x = p0.x; pp.y = p0.y; pp.z = p1.x; pp.w = p1.y; pf[ks] = __builtin_bit_cast(bf16x8, pp); }
        f32x4 acc[16];
#pragma unroll
        for (int nt = 0; nt < 16; ++nt) acc[nt] = (f32x4){0.f, 0.f, 0.f, 0.f};
#pragma unroll
        for (int ks = 0; ks < 4; ++ks) if (2 * ks <= wid) {
#pragma unroll
            for (int nt = 0; nt < 16; ++nt) { acc[nt] = __builtin_amdgcn_mfma_f32_16x16x32_bf16(tr_frag(sV + (ks * 32 + trow) * VSTR + (nt * 16 + tcol) * 2, VSTR), pf[ks], acc[nt], 0, 0, 0); } }
        LDS_BARRIER();
#pragma unroll
        for (int i = 0; i < 8; ++i) { const int id = ts + NTHREADS * i; *(LAS u32x4*)(sV + (id >> 4) * RSTR + (id & 15) * 16) = sr[i]; }
        u32x4 gsr[8]; int tg = lane; asm volatile("" : "+v"(tg));
#pragma unroll
        for (int i2 = 0; i2 < 8; ++i2) { const int id = tg + 64 * i2; gsr[i2] = __builtin_nontemporal_load((const u32x4*)(GS + (size_t)(tok0 + wid * 16 + (id >> 5)) * 1024 + h * 256 + (id & 31) * 8)); }
        const int nit = it + F.G; const bool has = nit < NIT;
        if (has) RC_LOAD(nit, qn);
        LDS_BARRIER();
#pragma unroll
        for (int ks = 0; ks < 4; ++ks)
#pragma unroll
            for (int nt = 0; nt < 16; ++nt) { acc[nt] = __builtin_amdgcn_mfma_f32_16x16x32_bf16(lds_frag(sV, nt * 16, ks * 32, fr, fq), qf[ks], acc[nt], 0, 0, 0); }
        float s = 0.f;
#pragma unroll
        for (int nt = 0; nt < 16; ++nt) s += (acc[nt][0] + acc[nt][1]) + (acc[nt][2] + acc[nt][3]);
        s += __shfl_xor(s, 16); s += __shfl_xor(s, 32);
        const float mu = s * (1.f / 256.f); float q = 0.f;
#pragma unroll
        for (int nt = 0; nt < 16; ++nt) { const f32x4 d = acc[nt] - mu; q += (d[0] * d[0] + d[1] * d[1]) + (d[2] * d[2] + d[3] * d[3]); }
        q += __shfl_xor(q, 16); q += __shfl_xor(q, 32);
        const float rstd = 1.0f / sqrtf(q * (1.f / 256.f) + NORM_EPS);
        LDS_BARRIER();
        LAS unsigned char* stg = sV + wid * (16 * 528); int tg2 = lane; asm volatile("" : "+v"(tg2));
#pragma unroll
        for (int i2 = 0; i2 < 8; ++i2) { const int id = tg2 + 64 * i2; *(LAS u32x4*)(stg + (id >> 5) * 528 + (id & 31) * 16) = gsr[i2]; }
        LDS_WAIT(); asm volatile("" ::: "memory");
#pragma unroll
        for (int nt = 0; nt < 16; ++nt) { const int col = nt * 16 + 4 * fq; const f32x4 gg = *(const f32x4*)(gng + h * 256 + col); LAS u32x2* sp = (LAS u32x2*)(stg + fr * 528 + col * 2); const u32x2 gs = *sp;
            const f32x4 y = (acc[nt] - mu) * rstd * gg;
            u32x2 o; o.x = pkbf(y[0] * bflo(gs.x), y[1] * bfhi(gs.x)); o.y = pkbf(y[2] * bflo(gs.y), y[3] * bfhi(gs.y));
            *sp = o; }
        LDS_WAIT(); asm volatile("" ::: "memory"); int tg3 = lane; asm volatile("" : "+v"(tg3));
#pragma unroll
        for (int i2 = 0; i2 < 8; ++i2) { const int id = tg3 + 64 * i2; *(u32x4*)(RETG + (size_t)(tok0 + wid * 16 + (id >> 5)) * 1024 + h * 256 + (id & 31) * 8) = *(const LAS u32x4*)(stg + (id >> 5) * 528 + (id & 31) * 16); }
        LDS_BARRIER();
        if (!has) break;
        it = nit;
#pragma unroll
        for (int ks = 0; ks < 4; ++ks) qf[ks] = qn[ks];
    }
#undef RC_LOAD
}

__device__ __forceinline__ void s5_scan(Frame& F, int first, int stride) {
    const int lane_o = otid() & 63;
    const float* VB = (const float*)(F.ws + WS_VBUF); bf16_t* AS5 = (bf16_t*)(F.ws + WS_AS5); const float* DB = (const float*)(F.ws + WS_DBUF);
    LAS float* TOT = (LAS float*)F.lds;
    for (int it = first; it < NB * S5G; it += stride) {
        const int b = it & 3, g = it >> 2, n = lane_o, seg = F.wave; const float dr = DB[(g * 64 + n) * 2], di = DB[(g * 64 + n) * 2 + 1];
        const size_t row0 = (size_t)g * 1024 + b * 256 + seg * 32;
        float vr[32], vi[32];
#pragma unroll
        for (int j = 0; j < 32; ++j) { vr[j] = VB[(row0 + j) * 128 + n]; vi[j] = VB[(row0 + j) * 128 + 64 + n]; }
        float lr[32], li[32]; float sr = 0.f, si = 0.f;
#pragma unroll
        for (int j = 0; j < 32; ++j) { lr[j] = sr; li[j] = si; const float tr = dr * sr - di * si + vr[j]; si = dr * si + di * sr + vi[j]; sr = tr; }
        TOT[(seg * 64 + n) * 2] = sr; TOT[(seg * 64 + n) * 2 + 1] = si;
        float p32r = 1.f, p32i = 0.f;
#pragma unroll
        for (int j = 0; j < 32; ++j) { const float tr = p32r * dr - p32i * di; p32i = p32r * di + p32i * dr; p32r = tr; }
        __syncthreads();
        float cr = 0.f, ci = 0.f;
        for (int s2 = 0; s2 < seg; ++s2) { const float tr_ = TOT[(s2 * 64 + n) * 2], ti_ = TOT[(s2 * 64 + n) * 2 + 1]; const float tr = p32r * cr - p32i * ci + tr_; ci = p32r * ci + p32i * cr + ti_; cr = tr; }
        float pr = 1.f, pi = 0.f;
#pragma unroll
        for (int j = 0; j < 32; ++j) {
            const float xr = lr[j] + pr * cr - pi * ci, xi = li[j] + pr * ci + pi * cr;
            bf16_t* ap = AS5 + (row0 + j) * 640 + 512 + n; ap[0] = (bf16_t)(pkbf(xr, 0.f) & 0xffff); ap[64] = (bf16_t)(pkbf(xi, 0.f) & 0xffff);
            const float tr = pr * dr - pi * di; pi = pr * di + pi * dr; pr = tr;
        }
        __syncthreads();
    }
}

#define TOP4_INS(val, idx) do { const float v_ = (val); const int i_ = (idx); const bool c0 = v_ > b0, c1 = v_ > b1, c2 = v_ > b2, c3 = v_ > b3; \
    b3 = c2 ? b2 : (c3 ? v_ : b3); i3 = c2 ? i2 : (c3 ? i_ : i3); b2 = c1 ? b1 : (c2 ? v_ : b2); i2 = c1 ? i1 : (c2 ? i_ : i2); \
    b1 = c0 ? b0 : (c1 ? v_ : b1); i1 = c0 ? i0 : (c1 ? i_ : i1); b0 = c0 ? v_ : b0; i0 = c0 ? i_ : i0; } while (0)
__device__ __forceinline__ void p8_router(Frame& F) {
    const int tid_o = otid(), lane_o = tid_o & 63;
    const int tid = tid_o, lane = lane_o, wid = F.wave, fr = lane & 15, fq = lane >> 4;
    LAS unsigned char* Wh = F.lds; LAS unsigned char* Wl = F.lds + 65536;
    LAS unsigned* lcnt = (LAS unsigned*)(F.lds + LDS_P8); LAS unsigned* lbase = lcnt + 32; LAS int* ent = (LAS int*)(F.lds + LDS_P8 + 256);
    const float* rw = inp(I_RW); const bf16_t* x1 = (const bf16_t*)(F.ws + WS_X1); unsigned char* H2 = (unsigned char*)(F.ws + WS_H2); const float* gg = inp(I_NFG); const float* rb = inp(I_RB);
    const float* rss = (const float*)(F.ws + WS_ROWSS);
    LAS float* gl = (LAS float*)ent;
    int* etok = (int*)(F.ws + WS_ETOK); int* inv = (int*)(F.ws + WS_INV); float* gate4 = (float*)(F.ws + WS_GATE4);
    for (int chn = blockIdx.x; chn < T / 128; chn += F.G) {
        const int tok = chn * 128 + wid * 16 + fr;
        const bf16_t* xrow = x1 + (size_t)tok * DM + fq * 8; unsigned char* hrow = H2 + (size_t)tok * DM + fq * 8; const LAS float* grow = gl + fq * 8;
        u32x4 xq[8];
#pragma unroll
        for (int i = 0; i < 8; ++i) xq[i] = __builtin_nontemporal_load((const u32x4*)(xrow + i * 32));
        { f32x4 wv[16];
#pragma unroll
          for (int it = 0; it < 16; ++it) wv[it] = *(const f32x4*)(rw + 4 * (tid + NTHREADS * it));
#pragma unroll
          for (int it = 0; it < 16; ++it) { const int i = 4 * (tid + NTHREADS * it), k = i >> 5, e0 = i & 31;
#pragma unroll
            for (int j = 0; j < 4; ++j) { const int e = e0 + j; const float w = wv[it][j];
                const unsigned hb = pkbf(w, 0.f) & 0xffffu; const float wl = w - __uint_as_float(hb << 16); const unsigned lb = pkbf(wl, 0.f) & 0xffffu;
                const int off = e * 2048 + ((((k >> 3) ^ (e & 15))) << 4) + (k & 7) * 2;
                *(LAS bf16_t*)(Wh + off) = (bf16_t)hb; *(LAS bf16_t*)(Wl + off) = (bf16_t)lb; } } }
        if (tid < 32) lcnt[tid] = 0u;
        if (tid < 256) *(LAS f32x4*)(gl + 4 * tid) = *(const f32x4*)(gg + 4 * tid);
        __syncthreads();
        float rs; { const f32x4* p = (const f32x4*)(rss + (size_t)tok * 16); const f32x4 a = p[0], b = p[1], c = p[2], d = p[3];
            const float ss = (((a[0] + a[1]) + (a[2] + a[3])) + ((b[0] + b[1]) + (b[2] + b[3]))) + (((c[0] + c[1]) + (c[2] + c[3])) + ((d[0] + d[1]) + (d[2] + d[3])));
            rs = 1.0f / sqrtf(ss * (1.f / DM) + NORM_EPS); }
        f32x4 acc[2]; acc[0] = (f32x4){0.f, 0.f, 0.f, 0.f}; acc[1] = acc[0];
#pragma nounroll
        for (int kb = 0; kb < 4; ++kb) {
        u32x4 xc[8];
#pragma unroll
        for (int i = 0; i < 8; ++i) xc[i] = xq[i];
        if (kb < 3) {
#pragma unroll
            for (int i = 0; i < 8; ++i) xq[i] = __builtin_nontemporal_load((const u32x4*)(xrow + (kb * 8 + 8 + i) * 32));
        }
#pragma unroll
        for (int ki = 0; ki < 8; ++ki) { const int ks = kb * 8 + ki;
            const u32x4 xp = xc[ki]; const f32x4 xa = (f32x4){bflo(xp.x), bfhi(xp.x), bflo(xp.y), bfhi(xp.y)}, xb = (f32x4){bflo(xp.z), bfhi(xp.z), bflo(xp.w), bfhi(xp.w)};
            const f32x4 ga = *(const LAS f32x4*)(grow + ks * 32), gb = *(const LAS f32x4*)(grow + ks * 32 + 4);
            const f32x4 ha = xa * rs * ga, hb = xb * rs * gb;
            u32x4 hp; hp.x = pkbf(ha[0], ha[1]); hp.y = pkbf(ha[2], ha[3]); hp.z = pkbf(hb[0], hb[1]); hp.w = pkbf(hb[2], hb[3]);
            { u32x2 h8; h8.x = pkfp8x4(ha[0], ha[1], ha[2], ha[3]); h8.y = pkfp8x4(hb[0], hb[1], hb[2], hb[3]); *(u32x2*)(hrow + ks * 32) = h8; }
            u32x4 lp; lp.x = pkbf(ha[0] - bflo(hp.x), ha[1] - bfhi(hp.x)); lp.y = pkbf(ha[2] - bflo(hp.y), ha[3] - bfhi(hp.y)); lp.z = pkbf(hb[0] - bflo(hp.z), hb[1] - bfhi(hp.z)); lp.w = pkbf(hb[2] - bflo(hp.w), hb[3] - bfhi(hp.w));
            const bf16x8 hv = __builtin_bit_cast(bf16x8, hp), lv = __builtin_bit_cast(bf16x8, lp);
#pragma unroll
            for (int et = 0; et < 2; ++et) { const int e = et * 16 + fr, off = e * 2048 + (((ks * 4 + fq) ^ (e & 15)) << 4);
                const bf16x8 wh = *(const LAS bf16x8*)(Wh + off), wl = *(const LAS bf16x8*)(Wl + off);
                acc[et] = __builtin_amdgcn_mfma_f32_16x16x32_bf16(wh, hv, acc[et], 0, 0, 0);
                acc[et] = __builtin_amdgcn_mfma_f32_16x16x32_bf16(wl, hv, acc[et], 0, 0, 0);
                acc[et] = __builtin_amdgcn_mfma_f32_16x16x32_bf16(wh, lv, acc[et], 0, 0, 0); }
        }
        }
        __syncthreads();
        LAS float* lgt = (LAS float*)F.lds + wid * 512;
#pragma unroll
        for (int et = 0; et < 2; ++et) { const f32x4 bb = *(const f32x4*)(rb + et * 16 + 4 * fq); *(LAS f32x4*)(lgt + fr * 32 + et * 16 + 4 * fq) = acc[et] + bb; }
        LDS_WAIT(); asm volatile("" ::: "memory");
        if (lane < 16) {
            float b0 = -__builtin_inff(), b1 = b0, b2 = b0, b3 = b0; int i0 = 0, i1 = 0, i2 = 0, i3 = 0;
#pragma unroll
            for (int q = 0; q < 8; ++q) { const f32x4 v4 = *(const LAS f32x4*)(lgt + lane * 32 + q * 4); TOP4_INS(v4[0], q * 4); TOP4_INS(v4[1], q * 4 + 1); TOP4_INS(v4[2], q * 4 + 2); TOP4_INS(v4[3], q * 4 + 3); }
            const float e1 = __expf(b1 - b0), e2 = __expf(b2 - b0), e3 = __expf(b3 - b0), inv = 1.0f / (1.0f + e1 + e2 + e3);
            const int t2 = chn * 128 + wid * 16 + lane; LAS int* en = ent + ((wid * 16 + lane) * 4) * 4;
            { const unsigned lp = atomicAdd((unsigned*)&lcnt[i0], 1u); en[0] = i0; en[1] = t2 * 4 + 0; en[2] = __float_as_int(inv); en[3] = (int)lp; }
            { const unsigned lp = atomicAdd((unsigned*)&lcnt[i1], 1u); en[4] = i1; en[5] = t2 * 4 + 1; en[6] = __float_as_int(e1 * inv); en[7] = (int)lp; }
            { const unsigned lp = atomicAdd((unsigned*)&lcnt[i2], 1u); en[8] = i2; en[9] = t2 * 4 + 2; en[10] = __float_as_int(e2 * inv); en[11] = (int)lp; }
            { const unsigned lp = atomicAdd((unsigned*)&lcnt[i3], 1u); en[12] = i3; en[13] = t2 * 4 + 3; en[14] = __float_as_int(e3 * inv); en[15] = (int)lp; }
        }
        __syncthreads();
        if (tid < 32) { lbase[tid] = atomicAdd(F.ctl + CW_ECNT + 64 * tid, lcnt[tid]); }
        __syncthreads();
        { const LAS int* en = ent + tid * 4; const int e = en[0]; const unsigned pos = lbase[e] + (unsigned)en[3];
          etok[(size_t)e * T + pos] = en[1]; inv[en[1]] = e * 32768 + (int)pos; gate4[en[1]] = __int_as_float(en[2]); }
        __syncthreads();
    }
}

__device__ __forceinline__ int build_tiles(Frame& F) {
    const int tid_o = otid();
    LAS int* pst = (LAS int*)(F.lds + LDS_PST); LAS int* cl = (LAS int*)(F.lds + LDS_CNT); LAS unsigned char* tile_e = F.lds + LDS_TILEE;
    __syncthreads();
    if (tid_o < 32) cl[tid_o] = (int)__hip_atomic_load(F.ctl + CW_ECNT + 64 * tid_o, __ATOMIC_RELAXED, __HIP_MEMORY_SCOPE_AGENT);
    __syncthreads();
    if (tid_o == 0) { int a = 0; for (int e = 0; e < 32; ++e) { pst[e] = a; a += (cl[e] + 255) & ~255; } pst[32] = a; }
    __syncthreads();
    const int ntiles = pst[32] >> 8;
    for (int t = tid_o; t < ntiles; t += NTHREADS) { int lo = 0;
        for (int st = 16; st >= 1; st >>= 1) if (t * 256 >= pst[lo + st]) lo += st;
        tile_e[t] = (unsigned char)lo; }
    __syncthreads();
    return ntiles;
}

__device__ __forceinline__ void p12_final(Frame& F, bool have_tables) {
    if (!have_tables) build_tiles(F);
    const int lane_o = otid() & 63; const LAS int* pst = (const LAS int*)(F.lds + LDS_PST);
    const int gw = F.vcu * NWAVES + F.wave, NGW = F.G * NWAVES; const unsigned char* YK = (const unsigned char*)(F.ws + WS_YK); const float* gg = inp(I_NFIN);
    const u32x4* inv = (const u32x4*)(F.ws + WS_INV); const f32x4* gate4 = (const f32x4*)(F.ws + WS_GATE4);
    f32x4 gv[4];
#pragma unroll
    for (int j = 0; j < 4; ++j) gv[j] = *((const f32x4*)gg + lane_o + 64 * j);
    u32x4 iv = inv[gw < T ? gw : 0]; f32x4 gt = gate4[gw < T ? gw : 0];
    for (int tok = gw; tok < T; tok += NGW) {
        const int r0 = pst[iv.x >> 15] + (int)(iv.x & 32767u), r1 = pst[iv.y >> 15] + (int)(iv.y & 32767u), r2 = pst[iv.z >> 15] + (int)(iv.z & 32767u), r3 = pst[iv.w >> 15] + (int)(iv.w & 32767u);
        const int* yr[4] = { (const int*)(YK + (size_t)r0 * DM) + lane_o, (const int*)(YK + (size_t)r1 * DM) + lane_o, (const int*)(YK + (size_t)r2 * DM) + lane_o, (const int*)(YK + (size_t)r3 * DM) + lane_o };
        const float gk[4] = { gt[0], gt[1], gt[2], gt[3] };
        const int nx = tok + NGW < T ? tok + NGW : tok; iv = inv[nx]; gt = gate4[nx];
        f32x4* xr = (f32x4*)(F.out + (size_t)tok * DM) + lane_o; const u32x2* x1r = (const u32x2*)((const bf16_t*)(F.ws + WS_X1) + (size_t)tok * DM) + lane_o; f32x4 v[4]; float s = 0.f;
#pragma unroll
        for (int j = 0; j < 4; ++j) { const u32x2 xp = __builtin_nontemporal_load(x1r + 64 * j); v[j] = (f32x4){bflo(xp.x), bfhi(xp.x), bflo(xp.y), bfhi(xp.y)};
#pragma unroll
            for (int k = 0; k < 4; ++k) { const int y = __builtin_nontemporal_load(yr[k] + 64 * j); const f32x2 lo = __builtin_amdgcn_cvt_pk_f32_fp8(y, false), hi = __builtin_amdgcn_cvt_pk_f32_fp8(y, true);
                v[j].x += gk[k] * lo[0]; v[j].y += gk[k] * lo[1]; v[j].z += gk[k] * hi[0]; v[j].w += gk[k] * hi[1]; }
            s += (v[j].x * v[j].x + v[j].y * v[j].y) + (v[j].z * v[j].z + v[j].w * v[j].w); }
        const float rs = 1.0f / sqrtf(wave_sum(s) * (1.f / DM) + NORM_EPS);
#pragma unroll
        for (int j = 0; j < 4; ++j) __builtin_nontemporal_store(v[j] * rs * gv[j], xr + 64 * j);
    }
}

constexpr int N_PHASES = 12;
struct Args { const float* in[26]; float* out; unsigned char* ws; int ph_lo, ph_hi, li, pad; };
__global__ void __launch_bounds__(NTHREADS, 2) fwd_kernel(Args args) {
    extern __shared__ __attribute__((aligned(16))) unsigned char lds[];
    Frame F;
    F.lds = (LAS unsigned char*)lds;
    const int tid_o = threadIdx.x; F.wave = __builtin_amdgcn_readfirstlane(tid_o >> 6);
    F.G = gridDim.x; { const int bx = blockIdx.x; F.vcu = (F.G % 8 == 0) ? (bx % 8) * (F.G / 8) + bx / 8 : bx; }
    F.ws = args.ws; F.ctl = (unsigned*)(args.ws + WS_CTL); F.out = args.out;
    for (int u = tid_o; u < (LDS_BYTES - LDSCTL_OFF) / 4; u += NTHREADS) ((LAS unsigned*)(F.lds + LDSCTL_OFF))[u] = 0u;
    __syncthreads();
    XcdBarrier bar; bar.bar = F.ctl + CW_BAR + args.li * XCD_BAR_WORDS; bar.x = 0; bar.st = nullptr;
    if (args.ph_hi - args.ph_lo > 1) bar = xcd_barrier_post(F.ctl + CW_BAR + args.li * XCD_BAR_WORDS, (volatile LAS unsigned*)(F.lds + LDSCTL_OFF) + 8);
    const int lo = args.ph_lo, hi = args.ph_hi;
#ifndef PHMASK
#define PHMASK 0xfff
#endif
#define IN(k) (((PHMASK >> (k)) & 1) && lo <= (k) && (k) < hi)
#define SEAM(k) do { if (IN(k) && IN((k) + 1)) xcd_barrier(bar); } while (0)
    LAS unsigned char* tile_e = F.lds + LDS_TILEE;

    if (IN(0)) { p0_prologue(F); SEAM(0); }
    if (IN(1)) {
        { pg8::Gemm g{(const void*)(F.ws + WS_H), (const void*)(F.ws + WS_WIN), 2048, 2048, 2048}; pg8::StaticOrder S; S.init(T / 256, IN_BF_TILES, F.G, (int)blockIdx.x);
          EpiInProj<false> E{F.ws};
          pg8::gemm_phase<EpiInProj<false>, pg8::StaticOrder, true>(F.lds, g, S, E); }
        { pg8::Gemm g{(const void*)(F.ws + WS_H8), (const void*)(F.ws + WS_WIN8), 1024, 1024, 1024}; pg8::StaticOrder S; S.init(T / 256, 22 - IN_BF_TILES, F.G, (int)blockIdx.x); S.rev = true;
          EpiInProj<true> E{F.ws};
          pg8::gemm_phase<EpiInProj<true>, pg8::StaticOrder, true>(F.lds, g, S, E); }
        SEAM(1);
    }
    if (IN(2)) {
        ret_pass_a(F);
        pg8::Gemm g{(const bf16_t*)(F.ws + WS_AS5), (const bf16_t*)(F.ws + WS_BTV), S5K * 2, 1024, 1024}; pg8::GroupOrder S; S.init(S5G, 4, 1, 1024, 256, F.G, (int)blockIdx.x);
        EpiS5V E{(float*)(F.ws + WS_VBUF)};
        pg8::gemm_phase<EpiS5V, pg8::GroupOrder, true>(F.lds, g, S, E);
        SEAM(2);
    }
    if (IN(3)) { ret_pass_b(F); s5_scan(F, F.vcu, F.G); SEAM(3); }
    if (IN(4)) {
        ret_pass_c(F);
        pg8::Gemm g{(const bf16_t*)(F.ws + WS_AS5), (const bf16_t*)(F.ws + WS_BTY), S5K * 2, S5K * 2, S5K * 2}; pg8::GroupOrder S; S.init(S5G, 4, 2, 1024, 512, F.G, (int)blockIdx.x);
        EpiS5Y E{(const bf16_t*)(F.ws + WS_AS5), (bf16_t*)(F.ws + WS_Z), inp(I_D)};
        pg8::gemm_phase<EpiS5Y, pg8::GroupOrder, true>(F.lds, g, S, E);
        SEAM(4);
    }
    if (IN(5)) {
        pg8::Gemm g{(const bf16_t*)(F.ws + WS_Z), (const bf16_t*)(F.ws + WS_WGLU), 1024, 1024, 1024}; pg8::StaticOrder S; S.init(T / 256, 2, F.G, (int)blockIdx.x);
        EpiGlu E{(const bf16_t*)(F.ws + WS_Z), (bf16_t*)(F.ws + WS_YS5), inp(I_BGLU)};
        pg8::gemm_phase<EpiGlu, pg8::StaticOrder, true>(F.lds, g, S, E);
        SEAM(5);
    }
    if (IN(6)) {
        pg8::ChainOrder S; S.so.init(T / 256, 4, F.G, (int)blockIdx.x);
        pg8::Gemm g{(const bf16_t*)(F.ws + WS_YS5), (const bf16_t*)(F.ws + WS_WCAT), 1024, 3072, 1024, (const bf16_t*)(F.ws + WS_RETG), 2048, 2048};
        EpiChain E{(const unsigned char*)(F.ws + WS_SA), (const unsigned char*)(F.ws + WS_SB), (bf16_t*)(F.ws + WS_MERGED)};
        pg8::gemm_phase<EpiChain, pg8::ChainOrder, true>(F.lds, g, S, E);
        SEAM(6);
    }
    if (IN(7)) {
        pg8::Gemm g{(const bf16_t*)(F.ws + WS_MERGED), (const bf16_t*)(F.ws + WS_WOUT), 2048, 2048, 2048}; pg8::StaticOrder S; S.init(T / 256, 4, F.G, (int)blockIdx.x);
        EpiResid E{inp(I_X), (bf16_t*)(F.ws + WS_X1), (float*)(F.ws + WS_ROWSS)};
        pg8::gemm_phase<EpiResid, pg8::StaticOrder, true>(F.lds, g, S, E);
        SEAM(7);
    }
    if (IN(8)) { p8_router(F); SEAM(8); }
    if (IN(9)) {
        const int ntiles = build_tiles(F);
        pg8::Gemm g{(const void*)(F.ws + WS_H2), (const void*)(F.ws + WS_W1), 1024, 1024, 1024};
        pg8::ExpertOrder<true> S; S.so.init(ntiles, 8, F.G, (int)blockIdx.x); S.tile_e = tile_e; S.nfull = 2048; S.pst = (const LAS int*)(F.lds + LDS_PST); S.cl = (const LAS int*)(F.lds + LDS_CNT); S.etok = (const int*)(F.ws + WS_ETOK); S.egate = nullptr;
        EpiSwiglu E{inp(I_B1), (unsigned char*)(F.ws + WS_ACT)};
        pg8::gemm_phase<EpiSwiglu, pg8::ExpertOrder<true>, true>(F.lds, g, S, E);
        SEAM(9);
    }
    if (IN(10)) {
        const int ntiles = IN(9) ? (((const LAS int*)(F.lds + LDS_PST))[32] >> 8) : build_tiles(F);
        pg8::Gemm g{(const void*)(F.ws + WS_ACT), (const void*)(F.ws + WS_W2), 1024, 1024, 1024};
        pg8::ExpertOrder<false> S; S.so.init(ntiles, 4, F.G, (int)blockIdx.x); S.so.rev = true;     S.tile_e = tile_e; S.nfull = 1024; S.pst = (const LAS int*)(F.lds + LDS_PST); S.cl = (const LAS int*)(F.lds + LDS_CNT); S.etok = (const int*)(F.ws + WS_ETOK); S.egate = nullptr;
#if defined(PROBE_FASTA)
        if (args.li == 1) S.amask = 0;
#endif
        EpiExpOut E{inp(I_B2), (unsigned char*)(F.ws + WS_YK)};
        pg8::gemm_phase<EpiExpOut, pg8::ExpertOrder<false>, true>(F.lds, g, S, E);
        SEAM(10);
    }
    if (IN(11)) { p12_final(F, IN(9)); }
#undef IN
#undef SEAM
}

extern "C" void kernel_launch(void* const* d_in, const int* in_sizes, int n_in, void* d_out, int out_size, void* d_ws, size_t ws_size, hipStream_t stream) {
    static int grid = 0;
    if (grid == 0) {
        if (n_in != 26 || in_sizes[0] != T * DM || out_size != T * DM || ws_size < WS_END) { fprintf(stderr, "kernel_launch: unexpected shapes (n_in %d, in0 %d, out %d, ws %zu); nothing launched\n", n_in, n_in > 0 ? in_sizes[0] : -1, out_size, ws_size); grid = -1; return; }
        int dev = 0, cus = 0, per_cu = 0;
        if (hipGetDevice(&dev) != hipSuccess || hipDeviceGetAttribute(&cus, hipDeviceAttributeMultiprocessorCount, dev) != hipSuccess) { grid = -1; return; }
        if (hipFuncSetAttribute((const void*)fwd_kernel, hipFuncAttributeMaxDynamicSharedMemorySize, LDS_BYTES) != hipSuccess) { fprintf(stderr, "kernel_launch: hipFuncSetAttribute failed\n"); grid = -1; return; }
        if (hipOccupancyMaxActiveBlocksPerMultiprocessor(&per_cu, (const void*)fwd_kernel, NTHREADS, LDS_BYTES) != hipSuccess || per_cu < 1) { fprintf(stderr, "kernel_launch: the occupancy query admits %d workgroups of this kernel per CU; nothing launched\n", per_cu); grid = -1; return; }
        (void)hipGetLastError();
        grid = cus;
    }
    if (grid < 0) return;
    (void)hipMemsetAsync((char*)d_ws + WS_CTL, 0, CTL_ZERO_BYTES, stream);
    Args a{};
    for (int i = 0; i < 26; ++i) a.in[i] = (const float*)d_in[i];
    a.out = (float*)d_out; a.ws = (unsigned char*)d_ws;
#if defined(PROBE_FASTA)
    a.ph_lo = 0; a.ph_hi = 10; a.li = 0; hipLaunchKernelGGL(fwd_kernel, dim3(grid), dim3(NTHREADS), LDS_BYTES, stream, a);
    a.ph_lo = 10; a.ph_hi = 11; a.li = 1; hipLaunchKernelGGL(fwd_kernel, dim3(grid), dim3(NTHREADS), LDS_BYTES, stream, a);
    a.ph_lo = 10; a.ph_hi = N_PHASES; a.li = 2; hipLaunchKernelGGL(fwd_kernel, dim3(grid), dim3(NTHREADS), LDS_BYTES, stream, a);
#elif defined(PROBE_PHASE)
    { const int k = PROBE_PHASE;
      a.ph_lo = 0; a.ph_hi = k + 1; a.li = 0; hipLaunchKernelGGL(fwd_kernel, dim3(grid), dim3(NTHREADS), LDS_BYTES, stream, a);
      if (k == 8) (void)hipMemsetAsync((char*)d_ws + WS_CTL + CW_ECNT * 4, 0, 32 * 256, stream);
      a.ph_lo = k; a.ph_hi = k + 1; a.li = 1; hipLaunchKernelGGL(fwd_kernel, dim3(grid), dim3(NTHREADS), LDS_BYTES, stream, a);
      if (k + 1 < N_PHASES) { a.ph_lo = k + 1; a.ph_hi = N_PHASES; a.li = 2; hipLaunchKernelGGL(fwd_kernel, dim3(grid), dim3(NTHREADS), LDS_BYTES, stream, a); } }
#else
    if (MK_N_LAUNCHES == 1) {
        a.ph_lo = 0; a.ph_hi = N_PHASES; a.li = 0;
        hipLaunchKernelGGL(fwd_kernel, dim3(grid), dim3(NTHREADS), LDS_BYTES, stream, a);
    } else {
        for (int p = 0; p < N_PHASES; ++p) { a.ph_lo = p; a.ph_hi = p + 1; a.li = 0; hipLaunchKernelGGL(fwd_kernel, dim3(grid), dim3(NTHREADS), LDS_BYTES, stream, a); }
    }
#endif
}
```
